# Optimizing an MI355X kernel written in HIP

```python
import math
import jax, jax.numpy as jnp
from jax import lax
import numpy as np

D_MODEL = 2048
BATCH = 4
SEQ = 4096
DEPTH = 1

N_MEM = 256
NORM_EPS = 1e-6

SSD_WIDTH = D_MODEL // 2
SSD_HEAD_DIM = 64
SSD_HEADS = SSD_WIDTH // SSD_HEAD_DIM
SSD_GROUPS = 2
SSD_HEADS_PER_GROUP = SSD_HEADS // SSD_GROUPS
SSD_STATE = 128
SSD_CONV = 4
SSD_CHUNK = 128
SSD_CONV_DIM = SSD_WIDTH + 2 * SSD_GROUPS * SSD_STATE
SSD_IN = SSD_WIDTH + SSD_CONV_DIM + SSD_HEADS

RWKV_WIDTH = D_MODEL - SSD_WIDTH
RWKV_HEAD_DIM = 64
RWKV_HEADS = RWKV_WIDTH // RWKV_HEAD_DIM
RWKV_DECAY_RANK = 96
RWKV_AAA_RANK = 96
RWKV_GATE_RANK = 256
RWKV_IN = 3 * RWKV_WIDTH + RWKV_DECAY_RANK + RWKV_AAA_RANK + RWKV_GATE_RANK
RWKV_LN_EPS = 64e-5

MIX_WIDTH = SSD_WIDTH + RWKV_WIDTH
D_IN = SSD_IN + RWKV_IN

XATTN_HEADS = 4
XATTN_HEAD_DIM = D_MODEL // XATTN_HEADS

D_FF = 4 * D_MODEL

kernel_name = "hymba_ssd_rwkv7_memxattn_block"


def rms_norm(x, g, eps=NORM_EPS):
    xf = x.astype(jnp.float32)
    y = xf * lax.rsqrt(jnp.mean(xf * xf, axis=-1, keepdims=True) + eps)
    return (y * g).astype(x.dtype)


def causal_depthwise_conv(u, w, b):
    y = lax.conv_general_dilated(
        u, w, window_strides=(1,), padding=[(w.shape[0] - 1, 0)],
        dimension_numbers=("NWC", "WIO", "NWC"), feature_group_count=u.shape[-1])
    return y + b


def ssd_mixer(u, conv_w, conv_b, dt_bias, a_log, d_skip, norm_g):
    f32 = jnp.float32
    bsz, seq, _ = u.shape
    G, E, P, N, Q = SSD_GROUPS, SSD_HEADS_PER_GROUP, SSD_HEAD_DIM, SSD_STATE, SSD_CHUNK
    nc = seq // Q
    z, xbc, dt = jnp.split(u, [SSD_WIDTH, SSD_WIDTH + SSD_CONV_DIM], axis=-1)
    xbc = jax.nn.silu(causal_depthwise_conv(xbc, conv_w, conv_b))
    xs, bm, cm = jnp.split(xbc, [SSD_WIDTH, SSD_WIDTH + G * N], axis=-1)
    xs = xs.astype(f32).reshape(bsz, nc, Q, G, E, P)
    bm = bm.astype(f32).reshape(bsz, nc, Q, G, N)
    cm = cm.astype(f32).reshape(bsz, nc, Q, G, N)
    dt = jax.nn.softplus(dt.astype(f32) + dt_bias.astype(f32))
    a = -jnp.exp(a_log.astype(f32))
    dt_c = dt.reshape(bsz, nc, Q, G, E)
    xdt = xs * dt_c[..., None]
    da = jnp.transpose(dt_c * a.reshape(G, E), (0, 1, 3, 4, 2))
    cs = jnp.cumsum(da, axis=-1)
    causal = jnp.tril(jnp.ones((Q, Q), dtype=bool))
    seg = cs[..., :, None] - cs[..., None, :]
    lmat = jnp.where(causal, jnp.exp(jnp.where(causal, seg, 0.0)), 0.0)
    cb = jnp.einsum('bclgn,bcsgn->bcgls', cm, bm)
    y_diag = jnp.einsum('bcgls,bcgels,bcsgep->bclgep', cb, lmat, xdt)
    decay_to_end = jnp.exp(cs[..., -1:] - cs)
    chunk_states = jnp.einsum('bcsgn,bcges,bcsgep->bcgepn', bm, decay_to_end, xdt)
    chunk_decay = jnp.exp(cs[..., -1])

    def carry_state(h, inp):
        st, dec = inp
        return h * dec[..., None, None] + st, h

    h0 = jnp.zeros((bsz, G, E, P, N), f32)
    _, start_states = lax.scan(carry_state, h0,
                               (jnp.moveaxis(chunk_states, 1, 0), jnp.moveaxis(chunk_decay, 1, 0)))
    start_states = jnp.moveaxis(start_states, 0, 1)
    y_off = jnp.einsum('bclgn,bcgepn,bcgel->bclgep', cm, start_states, jnp.exp(cs))
    y = y_diag + y_off + xs * d_skip.astype(f32).reshape(G, E, 1)
    y = y.reshape(bsz, seq, SSD_WIDTH) * jax.nn.silu(z.astype(f32))
    yg = y.reshape(bsz, seq, G, SSD_WIDTH // G)
    yg = yg * lax.rsqrt(jnp.mean(yg * yg, axis=-1, keepdims=True) + NORM_EPS)
    y = yg.reshape(bsz, seq, SSD_WIDTH) * norm_g
    return y.astype(u.dtype)


def rwkv7_mixer(u, mu, w0, w2, a0, a2, g2, k_k, k_a, r_k, ln_w, ln_b):
    f32 = jnp.float32
    bsz, seq, _ = u.shape
    H, N, W = RWKV_HEADS, RWKV_HEAD_DIM, RWKV_WIDTH
    uf = u.astype(f32)
    u_prev = jnp.pad(uf, ((0, 0), (1, 0), (0, 0)))[:, :-1]
    uf = uf + (u_prev - uf) * mu
    r, k, v, pw, pa, pg = jnp.split(
        uf, [W, 2 * W, 3 * W, 3 * W + RWKV_DECAY_RANK,
             3 * W + RWKV_DECAY_RANK + RWKV_AAA_RANK], axis=-1)
    w_log = -jax.nn.softplus(-(w0 + jnp.tanh(pw) @ w2)) - 0.5
    decay = jnp.exp(-jnp.exp(w_log))
    iclr = jax.nn.sigmoid(a0 + pa @ a2)
    gate = jax.nn.sigmoid(pg) @ g2
    heads = lambda t: t.reshape(bsz, seq, H, N)
    kk = heads(k * k_k)
    kk = kk / jnp.maximum(jnp.sqrt(jnp.sum(kk * kk, axis=-1, keepdims=True)), 1e-12)
    k = k * (1.0 + (iclr - 1.0) * k_a)
    r, k, v, decay, iclr = heads(r), heads(k), heads(v), heads(decay), heads(iclr)

    def step(state, inp):
        r_t, w_t, k_t, v_t, kk_t, a_t = inp
        sa = jnp.einsum('bhij,bhj->bhi', state, -kk_t)
        state = (state * w_t[:, :, None, :]
                 + sa[..., None] * (kk_t * a_t)[:, :, None, :]
                 + v_t[..., None] * k_t[:, :, None, :])
        return state, jnp.einsum('bhij,bhj->bhi', state, r_t)

    seq_first = lambda t: jnp.moveaxis(t, 1, 0)
    s0 = jnp.zeros((bsz, H, N, N), f32)
    _, y = lax.scan(step, s0, (seq_first(r), seq_first(decay), seq_first(k),
                               seq_first(v), seq_first(kk), seq_first(iclr)))
    y = jnp.moveaxis(y, 0, 1)
    mean = jnp.mean(y, axis=-1, keepdims=True)
    var = jnp.mean(jnp.square(y - mean), axis=-1, keepdims=True)
    y = ((y - mean) * lax.rsqrt(var + RWKV_LN_EPS)).reshape(bsz, seq, W) * ln_w + ln_b
    bonus = jnp.sum(r * k * r_k, axis=-1, keepdims=True) * v
    y = (y + bonus.reshape(bsz, seq, W)) * gate
    return y.astype(u.dtype)


def memory_cross_attention(h, m, wq, wk, wv, wo):
    bsz, seq, _ = h.shape
    q = (h @ wq).reshape(bsz, seq, XATTN_HEADS, XATTN_HEAD_DIM)
    k = (m @ wk).reshape(bsz, m.shape[1], XATTN_HEADS, XATTN_HEAD_DIM)
    v = (m @ wv).reshape(bsz, m.shape[1], XATTN_HEADS, XATTN_HEAD_DIM)
    scores = jnp.einsum('bshd,bmhd->bhsm', q, k).astype(jnp.float32) * (XATTN_HEAD_DIM ** -0.5)
    p = jax.nn.softmax(scores, axis=-1).astype(v.dtype)
    o = jnp.einsum('bhsm,bmhd->bshd', p, v).reshape(bsz, seq, D_MODEL)
    return o @ wo


def setup_inputs(seed: int = 0) -> dict:
    key = jax.random.key(seed)
    ks = iter(jax.random.split(key, 40))
    nrm = lambda shape, scale: jax.random.normal(next(ks), shape, jnp.float32) * scale
    uni = lambda shape, lo, hi: jax.random.uniform(next(ks), shape, jnp.float32, lo, hi)
    L = DEPTH
    dt0 = jnp.exp(uni((L, SSD_HEADS), math.log(1e-3), math.log(1e-1)))
    return {
        "x": nrm((BATCH, SEQ, D_MODEL), 1.0),
        "mem": nrm((BATCH, N_MEM, D_MODEL), 1.0),
        "norm_mix_g": 1.0 + nrm((L, D_MODEL), 0.02),
        "w_in": nrm((L, D_MODEL, D_IN), D_MODEL ** -0.5),
        "ssd_conv_w": nrm((L, SSD_CONV, 1, SSD_CONV_DIM), SSD_CONV ** -0.5),
        "ssd_conv_b": nrm((L, SSD_CONV_DIM), 0.01),
        "ssd_dt_bias": dt0 + jnp.log(-jnp.expm1(-dt0)),
        "ssd_a_log": jnp.log(uni((L, SSD_HEADS), 1.0, 16.0)),
        "ssd_d": 1.0 + nrm((L, SSD_HEADS), 0.1),
        "ssd_norm_g": 1.0 + nrm((L, SSD_WIDTH), 0.02),
        "rwkv_mu": uni((L, RWKV_IN), 0.0, 1.0),
        "rwkv_w0": uni((L, RWKV_WIDTH), -6.0, -1.0),
        "rwkv_w2": nrm((L, RWKV_DECAY_RANK, RWKV_WIDTH), 0.5 * RWKV_DECAY_RANK ** -0.5),
        "rwkv_a0": nrm((L, RWKV_WIDTH), 0.1),
        "rwkv_a2": nrm((L, RWKV_AAA_RANK, RWKV_WIDTH), RWKV_AAA_RANK ** -0.5),
        "rwkv_g2": nrm((L, RWKV_GATE_RANK, RWKV_WIDTH), RWKV_GATE_RANK ** -0.5),
        "rwkv_k_k": 0.85 + nrm((L, RWKV_WIDTH), 0.05),
        "rwkv_k_a": 1.0 + nrm((L, RWKV_WIDTH), 0.05),
        "rwkv_r_k": nrm((L, RWKV_HEADS, RWKV_HEAD_DIM), 0.1),
        "rwkv_ln_w": 1.0 + nrm((L, RWKV_WIDTH), 0.02),
        "rwkv_ln_b": nrm((L, RWKV_WIDTH), 0.01),
        "w_out": nrm((L, MIX_WIDTH, D_MODEL), MIX_WIDTH ** -0.5),
        "norm_x_g": 1.0 + nrm((L, D_MODEL), 0.02),
        "norm_mem_g": 1.0 + nrm((L, D_MODEL), 0.02),
        "xattn_wq": nrm((L, D_MODEL, D_MODEL), D_MODEL ** -0.5),
        "xattn_wk": nrm((L, D_MODEL, D_MODEL), D_MODEL ** -0.5),
        "xattn_wv": nrm((L, D_MODEL, D_MODEL), D_MODEL ** -0.5),
        "xattn_wo": nrm((L, D_MODEL, D_MODEL), D_MODEL ** -0.5),
        "norm_ffn_g": 1.0 + nrm((L, D_MODEL), 0.02),
        "ffn_w1": nrm((L, D_MODEL, D_FF), D_MODEL ** -0.5),
        "ffn_w2": nrm((L, D_FF, D_MODEL), D_FF ** -0.5),
        "final_norm_g": 1.0 + nrm((D_MODEL,), 0.02),
    }


def reference(x, mem, norm_mix_g, w_in, ssd_conv_w, ssd_conv_b, ssd_dt_bias, ssd_a_log,
              ssd_d, ssd_norm_g, rwkv_mu, rwkv_w0, rwkv_w2, rwkv_a0, rwkv_a2, rwkv_g2,
              rwkv_k_k, rwkv_k_a, rwkv_r_k, rwkv_ln_w, rwkv_ln_b, w_out, norm_x_g,
              norm_mem_g, xattn_wq, xattn_wk, xattn_wv, xattn_wo, norm_ffn_g, ffn_w1,
              ffn_w2, final_norm_g):
    for l in range(DEPTH):
        h = rms_norm(x, norm_mix_g[l])
        u = h @ w_in[l]
        y_ssd = ssd_mixer(u[..., :SSD_IN], ssd_conv_w[l], ssd_conv_b[l], ssd_dt_bias[l],
                          ssd_a_log[l], ssd_d[l], ssd_norm_g[l])
        y_rwkv = rwkv7_mixer(u[..., SSD_IN:], rwkv_mu[l], rwkv_w0[l], rwkv_w2[l], rwkv_a0[l],
                             rwkv_a2[l], rwkv_g2[l], rwkv_k_k[l], rwkv_k_a[l], rwkv_r_k[l],
                             rwkv_ln_w[l], rwkv_ln_b[l])
        x = x + jnp.concatenate([y_ssd, y_rwkv], axis=-1) @ w_out[l]
        h = rms_norm(x, norm_x_g[l])
        m = rms_norm(mem, norm_mem_g[l])
        x = x + memory_cross_attention(h, m, xattn_wq[l], xattn_wk[l], xattn_wv[l], xattn_wo[l])
        h = rms_norm(x, norm_ffn_g[l])
        x = x + jnp.square(jax.nn.relu(h @ ffn_w1[l])) @ ffn_w2[l]
    return rms_norm(x, final_norm_g)
```

```cpp
#include <hip/hip_runtime.h>
#include <hip/hip_cooperative_groups.h>
#include <cstdio>
namespace cg = cooperative_groups;

typedef unsigned short bf16_t;
typedef short bf16x8 __attribute__((ext_vector_type(8)));
typedef float f32x4 __attribute__((ext_vector_type(4)));
typedef float f32x2 __attribute__((ext_vector_type(2)));
typedef unsigned u32x4 __attribute__((ext_vector_type(4)));
typedef unsigned u32x2 __attribute__((ext_vector_type(2)));
#define LAS __attribute__((address_space(3)))

constexpr int T_TOK = 16384, SEQ = 4096, DM = 2048, NU = 6144, DFF = 8192;
constexpr int LDS_BYTES = 140 * 1024;
constexpr size_t MiB = 1u << 20;
constexpr size_t WS_WIN = 0, WS_WOUT = 24 * MiB, WS_WQ = 32 * MiB, WS_WK = 40 * MiB, WS_WV = 48 * MiB, WS_WO = 56 * MiB, WS_W1 = 64 * MiB, WS_W2 = 96 * MiB,
                 WS_LORA = 128 * MiB, WS_MN = 132 * MiB, WS_KX = 136 * MiB, WS_VT = 140 * MiB, WS_HN = 144 * MiB, WS_U = 208 * MiB,
                 WS_E = 400 * MiB, WS_A = 432 * MiB, WS_G = 464 * MiB, WS_BN = 496 * MiB, WS_CD = 497 * MiB, WS_BAR = 498 * MiB, WS_SS = 499 * MiB, WS_END = 500 * MiB;
constexpr size_t DO_ST = 0, DO_XC = 32 * MiB, DO_DT = 80 * MiB, DO_CS = 81 * MiB, DO_LA = 82 * MiB, DO_YR = 82 * MiB;

struct Args { const float* in[32]; float* out; unsigned char* ws; int ph_lo, ph_hi; };

__device__ __forceinline__ float bf2f(unsigned v) { return __uint_as_float(v << 16); }
__device__ __forceinline__ float bflo(unsigned v) { return __uint_as_float(v << 16); }
__device__ __forceinline__ float bfhi(unsigned v) { return __uint_as_float(v & 0xffff0000u); }
typedef __bf16 bf16x2_t __attribute__((ext_vector_type(2)));
__device__ __forceinline__ unsigned pk2(float lo, float hi) { bf16x2_t v = {(__bf16)lo, (__bf16)hi}; return __builtin_bit_cast(unsigned, v); }
__device__ __forceinline__ bf16_t f2bf(float f) { return (bf16_t)(pk2(f, 0.f) & 0xffffu); }
__device__ __forceinline__ float wave_sum(float v) {
#pragma unroll
    for (int o = 1; o < 64; o <<= 1) v += __shfl_xor(v, o);
    return v;
}
template <int CTRL> __device__ __forceinline__ float dppf(float x) { return __builtin_bit_cast(float, __builtin_amdgcn_update_dpp(0, __builtin_bit_cast(int, x), CTRL, 0xF, 0xF, true)); }
__device__ __forceinline__ float row16_sum(float x) { x += dppf<0xB1>(x); x += dppf<0x4E>(x); x += dppf<0x141>(x); x += dppf<0x140>(x); return x; }
__device__ __forceinline__ void row16_sum2(float& x, float& y) {
    x += dppf<0xB1>(x); y += dppf<0xB1>(y); x += dppf<0x4E>(x); y += dppf<0x4E>(y); x += dppf<0x141>(x); y += dppf<0x141>(y); x += dppf<0x140>(x); y += dppf<0x140>(y);
}
__device__ __forceinline__ float row16_max(float x) { x = fmaxf(x, dppf<0xB1>(x)); x = fmaxf(x, dppf<0x4E>(x)); x = fmaxf(x, dppf<0x141>(x)); x = fmaxf(x, dppf<0x140>(x)); return x; }
__device__ __forceinline__ float softplusf(float x) { return fmaxf(x, 0.f) + __logf(1.f + __expf(-fabsf(x))); }
__device__ __forceinline__ float sigmoidf_(float x) { return __builtin_amdgcn_rcpf(1.f + __expf(-x)); }
__device__ __forceinline__ float siluf_(float x) { return x * __builtin_amdgcn_rcpf(1.f + __expf(-x)); }
__device__ __forceinline__ f32x4 mfma16(bf16x8 a, bf16x8 b, f32x4 c) { return __builtin_amdgcn_mfma_f32_16x16x32_bf16(a, b, c, 0, 0, 0); }

template <int NF, int KT, bool TRANS>
__device__ __forceinline__ void wave_mma(f32x4 (&acc)[NF], const bf16_t* A, int sa, const bf16_t* B, int sb, int fr, int fq) {
#pragma unroll
    for (int k = 0; k < KT; k += 32) {
        const bf16x8 av = *(const bf16x8*)(A + fr * sa + k + 8 * fq);
#pragma unroll
        for (int f = 0; f < NF; ++f) {
            const bf16x8 bv = *(const bf16x8*)(B + (16 * f + fr) * sb + k + 8 * fq);
            acc[f] = TRANS ? mfma16(bv, av, acc[f]) : mfma16(av, bv, acc[f]);
        }
    }
}

namespace pg8 {
constexpr int BM = 256, BK = 64, HALF = 128, HTB = HALF * BK * 2, STAGE_BYTES = 8 * HTB, NXCD = 8, WGM = 4;
__device__ __forceinline__ int lds_byte(int r, int c) { const int st = (r >> 4) * 2 + (c >> 5), rr = r & 15, cc = c & 31, ob = rr * 64 + cc * 2; return st * 1024 + (ob ^ (((ob >> 9) & 1) << 5)); }
__device__ __forceinline__ void stage_rc(int b, int& R, int& C) { const int st = b / 1024, sb = b % 1024, swz = sb ^ (((sb >> 9) & 1) << 5); R = (st >> 1) * 16 + swz / 64; C = (st & 1) * 32 + (swz % 64) / 2; }
__device__ __forceinline__ int perm32(int rho) { const int n = rho >> 4, i = rho & 15; return 8 * (i >> 2) + 4 * n + (i & 3); }
struct Unit { int pm, pn; };
struct Gemm { const bf16_t* A; const bf16_t* Bt; int M, N, K; };
struct StaticOrder {
    int nM, nN, nwg, G, c;
    __device__ void init(int M, int N, int G_, int c_) { nM = M / BM; nN = N / BM; nwg = nM * nN; G = G_; c = c_; }
    __device__ bool next(int i, Unit& u) const {
        const long L = (long)i * G + c; if (L >= nwg) return false;
        int wgid = (int)L; { const int q = nwg / NXCD, r = nwg % NXCD, xcd = wgid % NXCD, off = wgid / NXCD; wgid = (xcd < r ? xcd * (q + 1) : r * (q + 1) + (xcd - r) * q) + off; }
        const int nig = WGM * nN, gid = wgid / nig, fm = gid * WGM, gsz = (nM - fm) < WGM ? (nM - fm) : WGM;
        u.pm = fm + ((wgid % nig) % gsz); u.pn = (wgid % nig) / gsz; return true;
    }
};
struct EpiBf16 {
    static constexpr bool PERM = true;
    bf16_t* O; int ldc; int act; const float* ss;
    __device__ __forceinline__ void operator()(const f32x4 (&acc)[2][2][4][2], const Unit& u, int wr, int wc, int fr, int fq) const {
        const int row0 = u.pm * BM + wr * 64 + fr, col0 = u.pn * BM + wc * 32 + 8 * fq;
#pragma unroll
        for (int ai = 0; ai < 2; ++ai)
#pragma unroll
            for (int m = 0; m < 4; ++m) { const int row = row0 + ai * HALF + m * 16; bf16_t* rowp = O + (size_t)row * ldc + col0;
                const float rs = ss ? rsqrtf(ss[row] * (1.f / 2048.f) + 1e-6f) : 1.f;
#pragma unroll
                for (int bj = 0; bj < 2; ++bj) { f32x4 v0 = acc[ai][bj][m][0] * rs, v1 = acc[ai][bj][m][1] * rs;
                    if (act == 1) {
#pragma unroll
                        for (int j = 0; j < 4; ++j) { const float a0 = fmaxf(v0[j], 0.f), a1 = fmaxf(v1[j], 0.f); v0[j] = a0 * a0; v1[j] = a1 * a1; } }
                    u32x4 w; w.x = pk2(v0[0], v0[1]); w.y = pk2(v0[2], v0[3]); w.z = pk2(v1[0], v1[1]); w.w = pk2(v1[2], v1[3]);
                    *(u32x4*)(rowp + bj * HALF) = w; } }
    }
};
template <bool BASE_BF16> struct EpiResBf16 {
    static constexpr bool PERM = true;
    const void* base; bf16_t* out; int ldc; float* ss;
    __device__ __forceinline__ void operator()(const f32x4 (&acc)[2][2][4][2], const Unit& u, int wr, int wc, int fr, int fq) const {
        const int row0 = u.pm * BM + wr * 64 + fr, col0 = u.pn * BM + wc * 32 + 8 * fq;
#pragma unroll
        for (int ai = 0; ai < 2; ++ai)
#pragma unroll
            for (int m = 0; m < 4; ++m) { const int row = row0 + ai * HALF + m * 16; const size_t off = (size_t)row * ldc + col0; float sq = 0.f;
#pragma unroll
                for (int bj = 0; bj < 2; ++bj) { f32x4 b0, b1;
                    if (BASE_BF16) { const u32x4 r = *(const u32x4*)((const bf16_t*)base + off + bj * HALF); b0 = (f32x4){bflo(r.x), bfhi(r.x), bflo(r.y), bfhi(r.y)}; b1 = (f32x4){bflo(r.z), bfhi(r.z), bflo(r.w), bfhi(r.w)}; }
                    else { b0 = __builtin_nontemporal_load((const f32x4*)((const float*)base + off + bj * HALF)); b1 = __builtin_nontemporal_load((const f32x4*)((const float*)base + off + bj * HALF + 4)); }
                    const f32x4 v0 = b0 + acc[ai][bj][m][0], v1 = b1 + acc[ai][bj][m][1];
                    sq += (v0[0] * v0[0] + v0[1] * v0[1]) + (v0[2] * v0[2] + v0[3] * v0[3]) + (v1[0] * v1[0] + v1[1] * v1[1]) + (v1[2] * v1[2] + v1[3] * v1[3]);
                    u32x4 w; w.x = pk2(v0[0], v0[1]); w.y = pk2(v0[2], v0[3]); w.z = pk2(v1[0], v1[1]); w.w = pk2(v1[2], v1[3]);
                    *(u32x4*)(out + off + bj * HALF) = w; }
                sq += __shfl_xor(sq, 16); sq += __shfl_xor(sq, 32);
                if (fq == 0) atomicAdd(ss + row, sq); }
    }
};
struct EpiResF32 {
    static constexpr bool PERM = true;
    const bf16_t* base; float* out; int ldc;
    __device__ __forceinline__ void operator()(const f32x4 (&acc)[2][2][4][2], const Unit& u, int wr, int wc, int fr, int fq) const {
        const int row0 = u.pm * BM + wr * 64 + fr, col0 = u.pn * BM + wc * 32 + 8 * fq;
#pragma unroll
        for (int ai = 0; ai < 2; ++ai)
#pragma unroll
            for (int m = 0; m < 4; ++m) { const size_t off = (size_t)(row0 + ai * HALF + m * 16) * ldc + col0;
#pragma unroll
                for (int bj = 0; bj < 2; ++bj) { const u32x4 r = *(const u32x4*)(base + off + bj * HALF);
                    const f32x4 b0 = (f32x4){bflo(r.x), bfhi(r.x), bflo(r.y), bfhi(r.y)}, b1 = (f32x4){bflo(r.z), bfhi(r.z), bflo(r.w), bfhi(r.w)};
                    *(f32x4*)(out + off + bj * HALF) = b0 + acc[ai][bj][m][0]; *(f32x4*)(out + off + bj * HALF + 4) = b1 + acc[ai][bj][m][1]; } }
    }
};
struct EpiLora {
    static constexpr bool PERM = true;
    bf16_t *E, *A, *G; const float *w0, *a0;
    template <int GRP>
    __device__ __forceinline__ void store(const f32x4 (&acc)[2][2][4][2], bf16_t* O, const float* bp, int row0, int col0) const {
        f32x4 bv[2][2];
#pragma unroll
        for (int bj = 0; bj < 2; ++bj)
#pragma unroll
            for (int n = 0; n < 2; ++n) bv[bj][n] = GRP == 2 ? (f32x4){0.f, 0.f, 0.f, 0.f} : *(const f32x4*)(bp + col0 + bj * HALF + 4 * n);
#pragma unroll
        for (int ai = 0; ai < 2; ++ai)
#pragma unroll
            for (int m = 0; m < 4; ++m) { bf16_t* rowp = O + (size_t)(row0 + ai * HALF + m * 16) * 1024 + col0;
#pragma unroll
                for (int bj = 0; bj < 2; ++bj) { f32x4 v0 = acc[ai][bj][m][0] + bv[bj][0], v1 = acc[ai][bj][m][1] + bv[bj][1];
                    if (GRP == 0) {
#pragma unroll
                        for (int j = 0; j < 4; ++j) { v0[j] = __expf(-softplusf(-v0[j]) - 0.5f); v1[j] = __expf(-softplusf(-v1[j]) - 0.5f); }
                    } else if (GRP == 1) {
#pragma unroll
                        for (int j = 0; j < 4; ++j) { v0[j] = sigmoidf_(v0[j]); v1[j] = sigmoidf_(v1[j]); }
                    }
                    u32x4 w; w.x = pk2(v0[0], v0[1]); w.y = pk2(v0[2], v0[3]); w.z = pk2(v1[0], v1[1]); w.w = pk2(v1[2], v1[3]);
                    *(u32x4*)(rowp + bj * HALF) = w; } }
    }
    __device__ __forceinline__ void operator()(const f32x4 (&acc)[2][2][4][2], const Unit& u, int wr, int wc, int fr, int fq) const {
        const int grp = u.pn >> 2;
        const int row0 = u.pm * BM + wr * 64 + fr, col0 = (u.pn & 3) * BM + wc * 32 + 8 * fq;
        if (grp == 0) store<0>(acc, E, w0, row0, col0);
        else if (grp == 1) store<1>(acc, A, a0, row0, col0);
        else store<2>(acc, G, a0, row0, col0);
    }
};

template <class Epi>
__device__ __forceinline__ void gemm_phase(LAS unsigned char* lds, const Gemm g, const StaticOrder& S, const Epi& E) {
    const int tid = threadIdx.x, wid = __builtin_amdgcn_readfirstlane(tid >> 6), lane = tid & 63, wr = wid >> 2, wc = wid & 3, fr = lane & 15, fq = lane >> 4;
    const int K = g.K, nt = K / BK;
    unsigned voffA[2], voffB[2];
#pragma unroll
    for (int i = 0; i < 2; ++i) { int R, C; stage_rc(tid * 16 + i * 8192, R, C); const int Rb = Epi::PERM ? ((R & ~31) + perm32(R & 31)) : R;
        voffA[i] = (unsigned)(R * K + C) * 2u; voffB[i] = (unsigned)(Rb * K + C) * 2u; }
    const size_t kstep = (size_t)(BK * 2);
    const size_t hstep = (size_t)HALF * K * 2;
    const size_t tstep = 2 * hstep;
    const unsigned ldsw = (unsigned)wid * 1024u;
    const int aoff = lds_byte(wr * 64 + fr, fq * 8), boff = lds_byte(wc * 32 + fr, fq * 8);
#define PG8_SA(b, h) (((b) * 2 + (h)) * HTB)
#define PG8_SB(b, h) ((4 + (b) * 2 + (h)) * HTB)
#define PG8_STAGE(bufoff, gbase, voff) do { _Pragma("unroll") for (int _i = 0; _i < 2; ++_i) \
        __builtin_amdgcn_global_load_lds((const unsigned*)((const char*)(gbase) + (voff)[_i]), (LAS unsigned*)(lds + (bufoff) + ldsw + _i * 8192), 16, 0, 0); } while (0)
#define PG8_LDA(dst, b, h) do { _Pragma("unroll") for (int m = 0; m < 4; ++m) _Pragma("unroll") for (int k = 0; k < 2; ++k) dst[m][k] = *(const LAS bf16x8*)(lds + PG8_SA(b, h) + aoff + m * 2048 + k * 1024); } while (0)
#define PG8_LDB(dst, b, h) do { _Pragma("unroll") for (int n = 0; n < 2; ++n) _Pragma("unroll") for (int k = 0; k < 2; ++k) dst[n][k] = *(const LAS bf16x8*)(lds + PG8_SB(b, h) + boff + n * 2048 + k * 1024); } while (0)
#define PG8_MMA(ai, bj, At, Bt) do { __builtin_amdgcn_s_setprio(1); _Pragma("unroll") for (int m = 0; m < 4; ++m) _Pragma("unroll") for (int n = 0; n < 2; ++n) _Pragma("unroll") for (int k = 0; k < 2; ++k) \
        acc[ai][bj][m][n] = __builtin_amdgcn_mfma_f32_16x16x32_bf16(Bt[n][k], At[m][k], acc[ai][bj][m][n], 0, 0, 0); __builtin_amdgcn_s_setprio(0); } while (0)
#define PG8_WAIT_V(n) asm volatile("s_waitcnt vmcnt(" #n ")" ::: "memory")
#define PG8_WAIT_L(n) asm volatile("s_waitcnt lgkmcnt(" #n ")" ::: "memory")
#define PG8_BAR __builtin_amdgcn_s_barrier()
#define PG8_SCHED __builtin_amdgcn_sched_barrier(0)
    Unit cur, nxt; int ui = 0;
    if (!S.next(0, cur)) return;
    f32x4 acc[2][2][4][2];
#pragma unroll
    for (int a = 0; a < 2; ++a)
#pragma unroll
        for (int b = 0; b < 2; ++b)
#pragma unroll
            for (int m = 0; m < 4; ++m)
#pragma unroll
                for (int n = 0; n < 2; ++n) acc[a][b][m][n] = (f32x4){0.f, 0.f, 0.f, 0.f};
    bf16x8 At[4][2], B0[2][2], B1[2][2];
    const char* cA = (const char*)g.A + (size_t)cur.pm * tstep; const char* cB = (const char*)g.Bt + (size_t)cur.pn * tstep;
    PG8_STAGE(PG8_SB(0, 0), cB, voffB); PG8_STAGE(PG8_SA(0, 0), cA, voffA); PG8_STAGE(PG8_SB(0, 1), cB + hstep, voffB); PG8_STAGE(PG8_SA(0, 1), cA + hstep, voffA);
    if (wr == 1) PG8_BAR;
    PG8_WAIT_V(4); PG8_BAR;
    PG8_STAGE(PG8_SB(1, 0), cB + kstep, voffB); PG8_STAGE(PG8_SA(1, 0), cA + kstep, voffA); PG8_STAGE(PG8_SB(1, 1), cB + hstep + kstep, voffB);
    PG8_WAIT_V(6); PG8_BAR;
    for (;;) {
        const bool has_next = S.next(ui + 1, nxt);
        const char* nA = has_next ? (const char*)g.A + (size_t)nxt.pm * tstep : cA; const char* nB = has_next ? (const char*)g.Bt + (size_t)nxt.pn * tstep : cB;
        for (int t = 0; t < nt; t += 2) {
            const bool last = (t == nt - 2);
            const char* a1 = cA + (size_t)(t + 1) * kstep;
            const char* a2 = last ? nA : cA + (size_t)(t + 2) * kstep; const char* b2 = last ? nB : cB + (size_t)(t + 2) * kstep;
            const char* a3 = a2 + kstep; const char* b3 = b2 + kstep;
            PG8_LDB(B0, 0, 0); PG8_SCHED; PG8_LDA(At, 0, 0); PG8_STAGE(PG8_SA(1, 1), a1 + hstep, voffA);
            PG8_WAIT_L(8); PG8_BAR; PG8_WAIT_L(0); PG8_MMA(0, 0, At, B0); PG8_BAR; PG8_SCHED;
            PG8_LDB(B1, 0, 1); PG8_STAGE(PG8_SB(0, 0), b2, voffB);
            PG8_BAR; PG8_WAIT_L(0); PG8_MMA(0, 1, At, B1); PG8_BAR;
            PG8_LDA(At, 0, 1); PG8_STAGE(PG8_SA(0, 0), a2, voffA);
            PG8_BAR; PG8_WAIT_L(0); PG8_MMA(1, 0, At, B0); PG8_BAR; PG8_SCHED;
            PG8_STAGE(PG8_SB(0, 1), b2 + hstep, voffB);
            PG8_WAIT_V(6); PG8_BAR; PG8_MMA(1, 1, At, B1); PG8_BAR;
            PG8_LDB(B0, 1, 0); PG8_SCHED; PG8_LDA(At, 1, 0); PG8_STAGE(PG8_SA(0, 1), a2 + hstep, voffA);
            PG8_WAIT_L(8); PG8_BAR; PG8_WAIT_L(0); PG8_MMA(0, 0, At, B0); PG8_BAR; PG8_SCHED;
            PG8_LDB(B1, 1, 1); PG8_STAGE(PG8_SB(1, 0), b3, voffB);
            PG8_BAR; PG8_WAIT_L(0); PG8_MMA(0, 1, At, B1); PG8_BAR;
            PG8_LDA(At, 1, 1); PG8_STAGE(PG8_SA(1, 0), a3, voffA);
            PG8_BAR; PG8_WAIT_L(0); PG8_MMA(1, 0, At, B0); PG8_BAR; PG8_SCHED;
            PG8_STAGE(PG8_SB(1, 1), b3 + hstep, voffB);
            PG8_WAIT_V(6); PG8_BAR; PG8_MMA(1, 1, At, B1); PG8_BAR;
        }
        E(acc, cur, wr, wc, fr, fq);
        if (!has_next) break;
#pragma unroll
        for (int a = 0; a < 2; ++a)
#pragma unroll
            for (int b = 0; b < 2; ++b)
#pragma unroll
                for (int m = 0; m < 4; ++m)
#pragma unroll
                    for (int n = 0; n < 2; ++n) acc[a][b][m][n] = (f32x4){0.f, 0.f, 0.f, 0.f};
        cur = nxt; cA = nA; cB = nB; ++ui;
    }
    PG8_WAIT_V(0);
    if (wr == 0) PG8_BAR;
    PG8_BAR;
#undef PG8_SA
#undef PG8_SB
#undef PG8_STAGE
#undef PG8_LDA
#undef PG8_LDB
#undef PG8_MMA
#undef PG8_WAIT_V
#undef PG8_WAIT_L
#undef PG8_BAR
#undef PG8_SCHED
}
}

template <class Epi>
__device__ __forceinline__ void run_gemm(unsigned char* lds, const bf16_t* A, const bf16_t* Bt, int M, int N, int K, const Epi& E, int Gv = -1, int cv = 0) {
    pg8::Gemm g{A, Bt, M, N, K}; pg8::StaticOrder S; if (Gv < 0) { Gv = (int)gridDim.x; cv = (int)blockIdx.x; } S.init(M, N, Gv, cv);
    pg8::gemm_phase<Epi>((LAS unsigned char*)lds, g, S, E);
    __syncthreads();
}

__device__ __forceinline__ void transpose_item(const float* W, int K, int N, bf16_t* WT, float* scr, int item, int nblk, int lane, const float* gk = nullptr) {
    const int kb = item / nblk, nb = item % nblk, k0 = 64 * kb, n0 = 32 * nb;
    const int n = n0 + (lane & 31);
#pragma unroll
    for (int i = 0; i < 32; ++i) { const int kk = 2 * i + (lane >> 5); scr[kk * 33 + (lane & 31)] = (n < N) ? __builtin_nontemporal_load(W + (size_t)(k0 + kk) * N + n) * (gk ? gk[k0 + kk] : 1.f) : 0.f; }
    __builtin_amdgcn_fence(__ATOMIC_RELEASE, "wavefront"); __builtin_amdgcn_wave_barrier(); __builtin_amdgcn_fence(__ATOMIC_ACQUIRE, "wavefront");
    const int c = lane & 7;
#pragma unroll
    for (int j = 0; j < 4; ++j) { const int nn = (lane >> 3) + 8 * j; const float* s = scr + (8 * c) * 33 + nn;
        u32x4 o; o.x = pk2(s[0 * 33], s[1 * 33]); o.y = pk2(s[2 * 33], s[3 * 33]); o.z = pk2(s[4 * 33], s[5 * 33]); o.w = pk2(s[6 * 33], s[7 * 33]);
        *(u32x4*)(WT + (size_t)(n0 + nn) * K + k0 + 8 * c) = o; }
    __builtin_amdgcn_fence(__ATOMIC_RELEASE, "wavefront"); __builtin_amdgcn_wave_barrier(); __builtin_amdgcn_fence(__ATOMIC_ACQUIRE, "wavefront");
}
__device__ __forceinline__ void rms_row_bf16(const float* x, const float* g, bf16_t* o, int lane) {
    f32x4 v[8]; float s = 0.f;
#pragma unroll
    for (int j = 0; j < 8; ++j) { v[j] = ((const f32x4*)x)[lane + 64 * j]; s += (v[j].x * v[j].x + v[j].y * v[j].y) + (v[j].z * v[j].z + v[j].w * v[j].w); }
    const float r = rsqrtf(wave_sum(s) * (1.f / 2048.f) + 1e-6f);
#pragma unroll
    for (int j = 0; j < 8; ++j) { const f32x4 gg = ((const f32x4*)g)[lane + 64 * j]; u32x2 w; w.x = pk2(v[j].x * r * gg.x, v[j].y * r * gg.y); w.y = pk2(v[j].z * r * gg.z, v[j].w * r * gg.w); ((u32x2*)o)[lane + 64 * j] = w; }
}
__device__ __forceinline__ void rms_row_f32(float* x, const float* g, int lane) {
    f32x4 v[8]; float s = 0.f;
#pragma unroll
    for (int j = 0; j < 8; ++j) { v[j] = ((const f32x4*)x)[lane + 64 * j]; s += (v[j].x * v[j].x + v[j].y * v[j].y) + (v[j].z * v[j].z + v[j].w * v[j].w); }
    const float r = rsqrtf(wave_sum(s) * (1.f / 2048.f) + 1e-6f);
#pragma unroll
    for (int j = 0; j < 8; ++j) { const f32x4 gg = ((const f32x4*)g)[lane + 64 * j]; ((f32x4*)x)[lane + 64 * j] = v[j] * r * gg; }
}
__device__ __forceinline__ void norm_rows_bf16(const float* X, const float* g, bf16_t* O, int rows) {
    const int lane = threadIdx.x & 63, gw = blockIdx.x * 8 + (threadIdx.x >> 6), NGW = gridDim.x * 8;
    int m = gw;
    for (; m + NGW < rows; m += 2 * NGW) {
        const float* xa = X + (size_t)m * DM; const float* xb = X + (size_t)(m + NGW) * DM;
        f32x4 va[8], vb[8]; float sa = 0.f, sb = 0.f;
#pragma unroll
        for (int j = 0; j < 8; ++j) { va[j] = __builtin_nontemporal_load((const f32x4*)xa + lane + 64 * j); vb[j] = __builtin_nontemporal_load((const f32x4*)xb + lane + 64 * j); }
#pragma unroll
        for (int j = 0; j < 8; ++j) { sa += (va[j].x * va[j].x + va[j].y * va[j].y) + (va[j].z * va[j].z + va[j].w * va[j].w); sb += (vb[j].x * vb[j].x + vb[j].y * vb[j].y) + (vb[j].z * vb[j].z + vb[j].w * vb[j].w); }
#pragma unroll
        for (int o = 1; o < 64; o <<= 1) { sa += __shfl_xor(sa, o); sb += __shfl_xor(sb, o); }
        const float ra = rsqrtf(sa * (1.f / 2048.f) + 1e-6f), rb = rsqrtf(sb * (1.f / 2048.f) + 1e-6f);
        u32x2* oa = (u32x2*)(O + (size_t)m * DM); u32x2* ob = (u32x2*)(O + (size_t)(m + NGW) * DM);
#pragma unroll
        for (int j = 0; j < 8; ++j) { const f32x4 gg = ((const f32x4*)g)[lane + 64 * j];
            u32x2 wa; wa.x = pk2(va[j].x * ra * gg.x, va[j].y * ra * gg.y); wa.y = pk2(va[j].z * ra * gg.z, va[j].w * ra * gg.w); oa[lane + 64 * j] = wa;
            u32x2 wb; wb.x = pk2(vb[j].x * rb * gg.x, vb[j].y * rb * gg.y); wb.y = pk2(vb[j].z * rb * gg.z, vb[j].w * rb * gg.w); ob[lane + 64 * j] = wb; }
    }
    for (; m < rows; m += NGW) rms_row_bf16(X + (size_t)m * DM, g, O + (size_t)m * DM, lane);
}

__device__ __forceinline__ void p0_prologue(const Args& a, unsigned char* lds) {
    const int tid = threadIdx.x, lane = tid & 63, wave = tid >> 6;
    float* scr = (float*)(lds + wave * 8448);
    const int gw = blockIdx.x * 8 + wave, NGW = gridDim.x * 8;
    unsigned char* ws = a.ws;
    constexpr int I_IN = 32 * 192, I_SQ = 32 * 64;
    constexpr int NITEMS = I_IN + 2 * I_SQ;
    for (int it = gw; it < NITEMS; it += NGW) {
        int r = it;
        if (r < I_IN) { transpose_item(a.in[3], DM, 6096, (bf16_t*)(ws + WS_WIN), scr, r, 192, lane); continue; } r -= I_IN;
        if (r < I_SQ) { transpose_item(a.in[25], DM, DM, (bf16_t*)(ws + WS_WK), scr, r, 64, lane); continue; } r -= I_SQ;
        transpose_item(a.in[26], DM, DM, (bf16_t*)(ws + WS_WV), scr, r, 64, lane);
    }
    {
        bf16_t* LT = (bf16_t*)(ws + WS_LORA); const float *w2 = a.in[12], *a2 = a.in[14], *g2 = a.in[15];
        for (int idx = blockIdx.x * 512 + tid; idx < 3072 * 512; idx += gridDim.x * 512) {
            const int n = idx >> 9, k = idx & 511, grp = n >> 10, nn = n & 1023; float v = 0.f;
            if (grp == 0) { if (k < 96) v = w2[k * 1024 + nn]; }
            else if (grp == 1) { if (k >= 96 && k < 192) v = a2[(k - 96) * 1024 + nn]; }
            else { if (k >= 192 && k < 448) v = g2[(k - 192) * 1024 + nn]; }
            LT[idx] = f2bf(v);
        }
    }
    { float* ssz = (float*)(ws + WS_SS); for (int i = blockIdx.x * 512 + tid; i < 3 * T_TOK; i += gridDim.x * 512) ssz[i] = 0.f; }
    norm_rows_bf16(a.in[0], a.in[2], (bf16_t*)(ws + WS_HN), T_TOK);
    norm_rows_bf16(a.in[1], a.in[23], (bf16_t*)(ws + WS_MN), 1024);
}

__device__ __forceinline__ void unpack8(const u32x4 u, float (&f)[8]) { f[0] = bflo(u.x); f[1] = bfhi(u.x); f[2] = bflo(u.y); f[3] = bfhi(u.y); f[4] = bflo(u.z); f[5] = bfhi(u.z); f[6] = bflo(u.w); f[7] = bfhi(u.w); }
__device__ __forceinline__ void lora_prep(const Args& a) {
    const bf16_t* U = (const bf16_t*)(a.ws + WS_U); bf16_t* LA = (bf16_t*)((unsigned char*)a.out + DO_LA); const float* mu = a.in[10];
#pragma unroll 2
    for (int idx = blockIdx.x * 512 + threadIdx.x; idx < T_TOK * 64; idx += gridDim.x * 512) {
        const int t = idx >> 6, c = (idx & 63) * 8; u32x4 w = (u32x4){0u, 0u, 0u, 0u};
        if (c < 448) {
            const bf16_t* up = U + (size_t)t * NU + 5648 + c;
            const u32x4 cu = *(const u32x4*)up; u32x4 pv = (u32x4){0u, 0u, 0u, 0u}; if (t & (SEQ - 1)) pv = *(const u32x4*)(up - NU);
            const f32x4 m0 = *(const f32x4*)(mu + 3072 + c), m1 = *(const f32x4*)(mu + 3072 + c + 4);
            float cur[8], prv[8], v[8]; unpack8(cu, cur); unpack8(pv, prv);
            const float mm[8] = {m0.x, m0.y, m0.z, m0.w, m1.x, m1.y, m1.z, m1.w};
#pragma unroll
            for (int j = 0; j < 8; ++j) { const float x = cur[j] + (prv[j] - cur[j]) * mm[j]; v[j] = c < 96 ? tanhf(x) : (c < 192 ? x : sigmoidf_(x)); }
            w.x = pk2(v[0], v[1]); w.y = pk2(v[2], v[3]); w.z = pk2(v[4], v[5]); w.w = pk2(v[6], v[7]);
        }
        *(u32x4*)(LA + (size_t)t * 512 + c) = w;
    }
}


__device__ __forceinline__ void ssd_passA(const Args& a, unsigned char* lds, int item) {
    const int tid = threadIdx.x, lane = tid & 63, wid = tid >> 6, fr = lane & 15, fq = lane >> 4;
    const int g = item & 1, c = (item >> 1) & 31, b = item >> 6;
    const int t0 = b * SEQ + c * 128;
    const bf16_t* U = (const bf16_t*)(a.ws + WS_U);
    unsigned char* dob = (unsigned char*)a.out;
    bf16_t* ST = (bf16_t*)(dob + DO_ST); bf16_t* XC = (bf16_t*)(dob + DO_XC); float* DT = (float*)(dob + DO_DT); float* CS = (float*)(dob + DO_CS);
    float* CD = (float*)(a.ws + WS_CD);
    float* dtl = (float*)lds; float* csl = dtl + 1024;
    bf16_t* BT = (bf16_t*)(lds + 8192); bf16_t* XT = BT + 128 * 136;
    const float* conv_w = a.in[4]; const float* conv_b = a.in[5];
    for (int idx = tid; idx < 1024; idx += 512) { const int e = idx >> 7, s = idx & 127, h = g * 8 + e;
        const float x = bf2f(U[(size_t)(t0 + s) * NU + 2560 + h]) + a.in[6][h]; const float dt = softplusf(x);
        dtl[idx] = dt; csl[idx] = dt * (-__expf(a.in[7][h])); }
    __syncthreads();
    { const int e = wid; const float v0 = csl[e * 128 + 2 * lane], v1 = csl[e * 128 + 2 * lane + 1]; float sum = v0 + v1;
#pragma unroll
      for (int off = 1; off < 64; off <<= 1) { const float n = __shfl_up(sum, off); if (lane >= off) sum += n; }
      const float excl = sum - (v0 + v1); csl[e * 128 + 2 * lane] = excl + v0; csl[e * 128 + 2 * lane + 1] = excl + v0 + v1; }
    __syncthreads();
    for (int idx = tid; idx < 1024; idx += 512) { const int e = idx >> 7, s = idx & 127, h = g * 8 + e; DT[(size_t)(t0 + s) * 16 + h] = dtl[idx]; CS[(size_t)(t0 + s) * 16 + h] = csl[idx]; }
    if (tid < 8) CD[(b * 32 + c) * 16 + g * 8 + tid] = __expf(csl[tid * 128 + 127]);
    for (int half = 0; half < 2; ++half) {
        const int ngroups = half ? 32 : 64, seglen = half ? 8 : 16;
        const int gi = tid % ngroups, seg = tid / ngroups;
        int col, kind;
        if (!half) { if (gi < 16) { col = 2048 + g * 128 + gi * 8; kind = 0; } else if (gi < 32) { col = 2304 + g * 128 + (gi - 16) * 8; kind = 1; } else { col = 1024 + g * 512 + (gi - 32) * 8; kind = 2; } }
        else { col = 1024 + g * 512 + 256 + gi * 8; kind = 2; }
        const int cc = col - 1024;
        float w0[8], w1[8], w2[8], w3[8], bb[8], x1[8], x2[8], x3[8], cur[8];
#pragma unroll
        for (int j = 0; j < 8; ++j) { w0[j] = conv_w[0 * 1536 + cc + j]; w1[j] = conv_w[1 * 1536 + cc + j]; w2[j] = conv_w[2 * 1536 + cc + j]; w3[j] = conv_w[3 * 1536 + cc + j]; bb[j] = conv_b[cc + j]; }
        const int s0 = seg * seglen;
        {
            const int sp = c * 128 + s0;
            const u32x4 z4 = (u32x4){0u, 0u, 0u, 0u};
            const u32x4 r1 = sp >= 3 ? *(const u32x4*)(U + (size_t)(t0 + s0 - 3) * NU + col) : z4;
            const u32x4 r2 = sp >= 2 ? *(const u32x4*)(U + (size_t)(t0 + s0 - 2) * NU + col) : z4;
            const u32x4 r3 = sp >= 1 ? *(const u32x4*)(U + (size_t)(t0 + s0 - 1) * NU + col) : z4;
            unpack8(r1, x1); unpack8(r2, x2); unpack8(r3, x3);
        }
        const int chg = cc - g * 512;
        const int e = (chg >> 6) & 7, eh = e & 3, p0 = chg & 63;
        for (int i = 0; i < seglen; ++i) {
            const int s = s0 + i;
            const u32x4 rc = *(const u32x4*)(U + (size_t)(t0 + s) * NU + col); unpack8(rc, cur);
            float v[8];
#pragma unroll
            for (int j = 0; j < 8; ++j) { const float o = bb[j] + w0[j] * x1[j] + w1[j] * x2[j] + w2[j] * x3[j] + w3[j] * cur[j]; v[j] = siluf_(o); x1[j] = x2[j]; x2[j] = x3[j]; x3[j] = cur[j]; }
            u32x4 w; w.x = pk2(v[0], v[1]); w.y = pk2(v[2], v[3]); w.z = pk2(v[4], v[5]); w.w = pk2(v[6], v[7]);
            *(u32x4*)(XC + (size_t)(t0 + s) * 1536 + cc) = w;
            if (kind == 0) {
#pragma unroll
                for (int j = 0; j < 8; ++j) BT[(gi * 8 + j) * 136 + s] = f2bf(v[j]);
            } else if (kind == 2) {
                const float sc = dtl[e * 128 + s] * __expf(csl[e * 128 + 127] - csl[e * 128 + s]);
#pragma unroll
                for (int j = 0; j < 8; ++j) XT[(eh * 64 + p0 + j) * 136 + s] = f2bf(v[j] * sc);
            }
        }
        __syncthreads();
        {
            const int eh2 = wid >> 1, nh = wid & 1, h = g * 8 + half * 4 + eh2;
            bf16_t* dst = ST + (size_t)((b * 32 + c) * 16 + h) * 8192;
#pragma unroll 1
            for (int rb = 0; rb < 4; ++rb) {
                f32x4 acc[4];
#pragma unroll
                for (int f = 0; f < 4; ++f) acc[f] = (f32x4){0.f, 0.f, 0.f, 0.f};
                wave_mma<4, 128, true>(acc, XT + (eh2 * 64 + rb * 16) * 136, 136, BT + (nh * 64) * 136, 136, fr, fq);
                const int p = rb * 16 + fr;
#pragma unroll
                for (int f = 0; f < 4; ++f) { u32x2 w; w.x = pk2(acc[f][0], acc[f][1]); w.y = pk2(acc[f][2], acc[f][3]); *(u32x2*)(dst + p * 128 + nh * 64 + 16 * f + 4 * fq) = w; }
            }
        }
        __syncthreads();
    }
}

__device__ __forceinline__ void ssd_state_scan(const Args& a) {
    bf16_t* ST = (bf16_t*)((unsigned char*)a.out + DO_ST); const float* CD = (const float*)(a.ws + WS_CD);
    for (int idx = blockIdx.x * 512 + threadIdx.x; idx < 4 * 16 * 2048; idx += gridDim.x * 512) {
        const int el = idx & 2047, h = (idx >> 11) & 15, b = idx >> 15;
        bf16_t* p0 = ST + (size_t)(b * 32 * 16 + h) * 8192 + el * 4;
        float h0 = 0.f, h1 = 0.f, h2 = 0.f, h3 = 0.f;
#pragma unroll 1
        for (int cb = 0; cb < 32; cb += 8) {
            u32x2 sv[8]; float dec[8];
#pragma unroll
            for (int c = 0; c < 8; ++c) { sv[c] = *(const u32x2*)(p0 + (size_t)(cb + c) * 16 * 8192); dec[c] = CD[(b * 32 + cb + c) * 16 + h]; }
#pragma unroll
            for (int c = 0; c < 8; ++c) {
                u32x2 w; w.x = pk2(h0, h1); w.y = pk2(h2, h3);
                *(u32x2*)(p0 + (size_t)(cb + c) * 16 * 8192) = w;
                h0 = h0 * dec[c] + bflo(sv[c].x); h1 = h1 * dec[c] + bfhi(sv[c].x); h2 = h2 * dec[c] + bflo(sv[c].y); h3 = h3 * dec[c] + bfhi(sv[c].y);
            }
        }
    }
}

__device__ __forceinline__ void ssd_passC(const Args& a, unsigned char* lds, int item) {
    const int tid = threadIdx.x, lane = tid & 63, wid = tid >> 6, fr = lane & 15, fq = lane >> 4;
    const int g = item & 1, c = (item >> 1) & 31, b = item >> 6;
    const int t0 = b * SEQ + c * 128;
    const bf16_t* U = (const bf16_t*)(a.ws + WS_U);
    unsigned char* dob = (unsigned char*)a.out;
    const bf16_t* ST = (const bf16_t*)(dob + DO_ST); const bf16_t* XC = (const bf16_t*)(dob + DO_XC); const float* DT = (const float*)(dob + DO_DT); const float* CS = (const float*)(dob + DO_CS);
    bf16_t* YM = (bf16_t*)(a.ws + WS_HN);
    float* dtl = (float*)lds; float* csl = dtl + 1024;
    bf16_t* Cn = (bf16_t*)(lds + 8192); bf16_t* Bn = Cn + 128 * 136; bf16_t* XdT = Bn + 128 * 136; bf16_t* StL = XdT + 64 * 136;
    bf16_t* Ml = Bn;
    for (int idx = tid; idx < 1024; idx += 512) { const int e = idx >> 7, s = idx & 127; dtl[idx] = DT[(size_t)(t0 + s) * 16 + g * 8 + e]; csl[idx] = CS[(size_t)(t0 + s) * 16 + g * 8 + e]; }
    for (int idx = tid; idx < 2048; idx += 512) { const int r = idx >> 4, ch = idx & 15;
        *(u32x4*)(Cn + r * 136 + ch * 8) = *(const u32x4*)(XC + (size_t)(t0 + r) * 1536 + 1280 + g * 128 + ch * 8);
        *(u32x4*)(Bn + r * 136 + ch * 8) = *(const u32x4*)(XC + (size_t)(t0 + r) * 1536 + 1024 + g * 128 + ch * 8); }
    __syncthreads();
    f32x4 cb[8];
#pragma unroll
    for (int f = 0; f < 8; ++f) cb[f] = (f32x4){0.f, 0.f, 0.f, 0.f};
    wave_mma<8, 128, false>(cb, Cn + (16 * wid) * 136, 136, Bn, 136, fr, fq);
    __syncthreads();
    float ssum = 0.f;
    const int lrow = 16 * wid + fr;
#pragma unroll 1
    for (int e = 0; e < 8; ++e) {
        const int h = g * 8 + e;
#pragma unroll
        for (int f = 0; f < 8; ++f)
#pragma unroll
            for (int j = 0; j < 4; ++j) { const int l = 16 * wid + 4 * fq + j, s = 16 * f + fr;
                const float m = (s <= l) ? cb[f][j] * __expf(csl[e * 128 + l] - csl[e * 128 + s]) : 0.f;
                Ml[l * 136 + s] = f2bf(m); }
        { const int s = tid & 127, pg = tid >> 7; const bf16_t* src = XC + (size_t)(t0 + s) * 1536 + g * 512 + e * 64 + pg * 16;
          const u32x4 r0 = *(const u32x4*)src, r1 = *(const u32x4*)(src + 8); float x0[8], x1[8]; unpack8(r0, x0); unpack8(r1, x1);
          const float dts = dtl[e * 128 + s];
#pragma unroll
          for (int j = 0; j < 8; ++j) { XdT[(pg * 16 + j) * 136 + s] = f2bf(x0[j] * dts); XdT[(pg * 16 + 8 + j) * 136 + s] = f2bf(x1[j] * dts); } }
        { const bf16_t* src = ST + (size_t)((b * 32 + c) * 16 + h) * 8192;
          for (int idx = tid; idx < 1024; idx += 512) { const int r = idx >> 4, ch = idx & 15; *(u32x4*)(StL + r * 136 + ch * 8) = *(const u32x4*)(src + r * 128 + ch * 8); } }
        __syncthreads();
        f32x4 yd[4], yo[4];
#pragma unroll
        for (int f = 0; f < 4; ++f) { yd[f] = (f32x4){0.f, 0.f, 0.f, 0.f}; yo[f] = (f32x4){0.f, 0.f, 0.f, 0.f}; }
        wave_mma<4, 128, true>(yd, Ml + (16 * wid) * 136, 136, XdT, 136, fr, fq);
        wave_mma<4, 128, true>(yo, Cn + (16 * wid) * 136, 136, StL, 136, fr, fq);
        const float ecs = __expf(csl[e * 128 + lrow]), Dh = a.in[8][h];
#pragma unroll
        for (int f = 0; f < 4; ++f) { const int ch = g * 512 + e * 64 + 16 * f + 4 * fq;
            const u32x2 xr = *(const u32x2*)(XC + (size_t)(t0 + lrow) * 1536 + ch); const u32x2 zr = *(const u32x2*)(U + (size_t)(t0 + lrow) * NU + ch);
            const float xs[4] = {bflo(xr.x), bfhi(xr.x), bflo(xr.y), bfhi(xr.y)}; const float zz[4] = {bflo(zr.x), bfhi(zr.x), bflo(zr.y), bfhi(zr.y)};
            float y[4];
#pragma unroll
            for (int j = 0; j < 4; ++j) { y[j] = (yd[f][j] + ecs * yo[f][j] + xs[j] * Dh) * siluf_(zz[j]); ssum += y[j] * y[j]; }
            u32x2 w; w.x = pk2(y[0], y[1]); w.y = pk2(y[2], y[3]);
            *(u32x2*)(YM + (size_t)(t0 + lrow) * DM + ch) = w; }
        __syncthreads();
    }
    ssum += __shfl_xor(ssum, 16); ssum += __shfl_xor(ssum, 32);
    const float rstd = rsqrtf(ssum * (1.f / 512.f) + 1e-6f);
    const float* ng = a.in[9];
#pragma unroll 1
    for (int e = 0; e < 8; ++e)
#pragma unroll
        for (int f = 0; f < 4; ++f) { const int ch = g * 512 + e * 64 + 16 * f + 4 * fq; bf16_t* p = YM + (size_t)(t0 + lrow) * DM + ch;
            const u32x2 yr = *(const u32x2*)p; const f32x4 gg = *(const f32x4*)(ng + ch);
            u32x2 w; w.x = pk2(bflo(yr.x) * rstd * gg.x, bfhi(yr.x) * rstd * gg.y); w.y = pk2(bflo(yr.y) * rstd * gg.z, bfhi(yr.y) * rstd * gg.w);
            *(u32x2*)p = w; }
    __syncthreads();
}

constexpr int LATE_SQ = 32 * 64, LATE_1 = 32 * 256, LATE_2 = 128 * 64, LATE_ITEMS = 3 * LATE_SQ + LATE_1 + LATE_2;
struct LateTile { const float* W; bf16_t* WT; const float* gk; int K, N, k0, n0; };
__device__ __forceinline__ LateTile late_decode(const Args& a, int it) {
    unsigned char* ws = a.ws; LateTile d; d.gk = nullptr; int r = it, nblk;
    if (r < LATE_SQ) { d.W = a.in[21]; d.WT = (bf16_t*)(ws + WS_WOUT); d.K = DM; d.N = DM; nblk = 64; }
    else if ((r -= LATE_SQ) < LATE_SQ) { d.W = a.in[24]; d.WT = (bf16_t*)(ws + WS_WQ); d.K = DM; d.N = DM; nblk = 64; d.gk = a.in[22]; }
    else if ((r -= LATE_SQ) < LATE_SQ) { d.W = a.in[27]; d.WT = (bf16_t*)(ws + WS_WO); d.K = DM; d.N = DM; nblk = 64; }
    else if ((r -= LATE_SQ) < LATE_1) { d.W = a.in[29]; d.WT = (bf16_t*)(ws + WS_W1); d.K = DM; d.N = DFF; nblk = 256; d.gk = a.in[28]; }
    else { r -= LATE_1; d.W = a.in[30]; d.WT = (bf16_t*)(ws + WS_W2); d.K = DFF; d.N = DM; nblk = 64; }
    d.k0 = 64 * (r / nblk); d.n0 = 32 * (r % nblk); return d;
}
__device__ __forceinline__ void late_load(const LateTile& d, int sub, float (&v)[8], int lane) {
#pragma unroll
    for (int i = 0; i < 8; ++i) { const int kk = d.k0 + 16 * sub + 2 * i + (lane >> 5); v[i] = __builtin_nontemporal_load(d.W + (size_t)kk * d.N + d.n0 + (lane & 31)) * (d.gk ? d.gk[kk] : 1.f); }
}
__device__ __forceinline__ void late_stash(int sub, const float (&v)[8], float* scr, int lane) {
#pragma unroll
    for (int i = 0; i < 8; ++i) scr[(16 * sub + 2 * i + (lane >> 5)) * 33 + (lane & 31)] = v[i];
}
__device__ __forceinline__ void late_flush(const LateTile& d, float* scr, int lane) {
    __builtin_amdgcn_fence(__ATOMIC_RELEASE, "wavefront"); __builtin_amdgcn_wave_barrier(); __builtin_amdgcn_fence(__ATOMIC_ACQUIRE, "wavefront");
    const int c = lane & 7;
#pragma unroll
    for (int j = 0; j < 4; ++j) { const int nn = (lane >> 3) + 8 * j; const float* s = scr + (8 * c) * 33 + nn;
        u32x4 o; o.x = pk2(s[0 * 33], s[1 * 33]); o.y = pk2(s[2 * 33], s[3 * 33]); o.z = pk2(s[4 * 33], s[5 * 33]); o.w = pk2(s[6 * 33], s[7 * 33]);
        __builtin_nontemporal_store(o, (u32x4*)(d.WT + (size_t)(d.n0 + nn) * d.K + d.k0 + 8 * c)); }
    __builtin_amdgcn_fence(__ATOMIC_RELEASE, "wavefront"); __builtin_amdgcn_wave_barrier(); __builtin_amdgcn_fence(__ATOMIC_ACQUIRE, "wavefront");
}

struct RwRaw { u32x2 rc, rp, kc, kp, vc, vp, ee, aa; };
struct RwStep { f32x4 nkk, wr, w, kka, k2; float vi; f32x2 cc; };
__device__ __forceinline__ void rw_load(RwRaw& r, const bf16_t* U, const bf16_t* Eb, const bf16_t* Ab, int b, int sp, int chn) {
    const size_t t = (size_t)b * SEQ + sp; const bf16_t* ur = U + t * NU + 2576 + chn;
    r.rc = *(const u32x2*)ur; r.kc = *(const u32x2*)(ur + 1024); r.vc = *(const u32x2*)(ur + 2048);
    if (sp > 0) { r.rp = *(const u32x2*)(ur - NU); r.kp = *(const u32x2*)(ur - NU + 1024); r.vp = *(const u32x2*)(ur - NU + 2048); } else { r.rp = (u32x2){0u, 0u}; r.kp = r.rp; r.vp = r.rp; }
    r.ee = *(const u32x2*)(Eb + t * 1024 + chn); r.aa = *(const u32x2*)(Ab + t * 1024 + chn);
}
__device__ __forceinline__ void rwkv_scan(const Args& a, unsigned char* lds, int item, bool do_late) {
    const int tid = threadIdx.x, lane = tid & 63, wid = tid >> 6;
    const int quarter = item & 3, h = (item >> 2) & 15, b = item >> 6;
    const bf16_t* U = (const bf16_t*)(a.ws + WS_U); const bf16_t* Eb = (const bf16_t*)(a.ws + WS_E); const bf16_t* Ab = (const bf16_t*)(a.ws + WS_A);
    float* BN = (float*)(a.ws + WS_BN); bf16_t* YR = (bf16_t*)((unsigned char*)a.out + DO_YR);
    float* OP = (float*)lds;
    float* VV = OP + 2 * 10240;
    float* CC = VV + 2 * 2048;
    float* YB = CC + 2 * 64;
    if (wid >= 4) {
        const int ptid = tid - 256, cq = ptid & 15, tt0 = ptid >> 4, chn = h * 64 + 4 * cq;
        const float* mu = a.in[10];
        float mur[4], muk[4], muv[4], kkw[4], kaw[4], rkw[4];
#pragma unroll
        for (int j = 0; j < 4; ++j) { mur[j] = mu[chn + j]; muk[j] = mu[1024 + chn + j]; muv[j] = mu[2048 + chn + j]; kkw[j] = a.in[16][chn + j]; kaw[j] = a.in[17][chn + j]; rkw[j] = a.in[18][chn + j]; }
        float* lscr = (float*)(lds + 102912 + (wid - 4) * 8448);
        const int NPW = (int)gridDim.x * 4; int late_it = (int)blockIdx.x * 4 + (wid - 4); int late_sub = 0; LateTile ld_{}; float lv[8];
        RwRaw raw[2];
        rw_load(raw[0], U, Eb, Ab, b, tt0, chn); rw_load(raw[1], U, Eb, Ab, b, tt0 + 16, chn);
#pragma unroll 1
        for (int chunk = 0; chunk <= 128; ++chunk) {
            const bool late_on = do_late && chunk >= 2 && late_it < LATE_ITEMS;
            if (late_on) { if (late_sub == 0) ld_ = late_decode(a, late_it); late_load(ld_, late_sub, lv, lane); }
            if (chunk < 128) {
                float* OPb = OP + (chunk & 1) * 10240; float* VVb = VV + (chunk & 1) * 2048; float* CCb = CC + (chunk & 1) * 64;
#pragma unroll
                for (int k2i = 0; k2i < 2; ++k2i) {
                    const RwRaw rr = raw[k2i]; const int tt = tt0 + 16 * k2i;
                    const float rcf[4] = {bflo(rr.rc.x), bfhi(rr.rc.x), bflo(rr.rc.y), bfhi(rr.rc.y)}, rpf[4] = {bflo(rr.rp.x), bfhi(rr.rp.x), bflo(rr.rp.y), bfhi(rr.rp.y)};
                    const float kcf[4] = {bflo(rr.kc.x), bfhi(rr.kc.x), bflo(rr.kc.y), bfhi(rr.kc.y)}, kpf[4] = {bflo(rr.kp.x), bfhi(rr.kp.x), bflo(rr.kp.y), bfhi(rr.kp.y)};
                    const float vcf[4] = {bflo(rr.vc.x), bfhi(rr.vc.x), bflo(rr.vc.y), bfhi(rr.vc.y)}, vpf[4] = {bflo(rr.vp.x), bfhi(rr.vp.x), bflo(rr.vp.y), bfhi(rr.vp.y)};
                    const float ef[4] = {bflo(rr.ee.x), bfhi(rr.ee.x), bflo(rr.ee.y), bfhi(rr.ee.y)}, af[4] = {bflo(rr.aa.x), bfhi(rr.aa.x), bflo(rr.aa.y), bfhi(rr.aa.y)};
                    if (chunk + 1 < 128) rw_load(raw[k2i], U, Eb, Ab, b, (chunk + 1) * 32 + tt, chn);
                    float r[4], k[4], v[4], w[4], kk[4], k2[4], kka[4], wr[4]; float ss = 0.f, c1 = 0.f, c2 = 0.f, bn = 0.f;
#pragma unroll
                    for (int j = 0; j < 4; ++j) { r[j] = rcf[j] + (rpf[j] - rcf[j]) * mur[j]; k[j] = kcf[j] + (kpf[j] - kcf[j]) * muk[j]; v[j] = vcf[j] + (vpf[j] - vcf[j]) * muv[j];
                        w[j] = __expf(-ef[j]); kk[j] = k[j] * kkw[j]; ss += kk[j] * kk[j]; }
                    ss = row16_sum(ss);
                    const float inv = __builtin_amdgcn_rsqf(fmaxf(ss, 1e-24f));
#pragma unroll
                    for (int j = 0; j < 4; ++j) { kk[j] *= inv; k2[j] = k[j] * (1.f + (af[j] - 1.f) * kaw[j]); kka[j] = kk[j] * af[j]; wr[j] = w[j] * r[j];
                        c1 += kka[j] * r[j]; c2 += k2[j] * r[j]; bn += r[j] * k2[j] * rkw[j]; }
                    c1 = row16_sum(c1); c2 = row16_sum(c2); bn = row16_sum(bn);
                    float* op = OPb + tt * 320 + cq * 20;
                    *(f32x4*)(op) = (f32x4){-kk[0], -kk[1], -kk[2], -kk[3]};
                    *(f32x4*)(op + 4) = (f32x4){wr[0], wr[1], wr[2], wr[3]};
                    *(f32x4*)(op + 8) = (f32x4){w[0], w[1], w[2], w[3]};
                    *(f32x4*)(op + 12) = (f32x4){kka[0], kka[1], kka[2], kka[3]};
                    *(f32x4*)(op + 16) = (f32x4){k2[0], k2[1], k2[2], k2[3]};
                    *(f32x4*)(VVb + tt * 64 + 4 * cq) = (f32x4){v[0], v[1], v[2], v[3]};
                    if (cq == 0) { CCb[2 * tt] = c1; CCb[2 * tt + 1] = c2; if (quarter == 0) BN[((size_t)b * SEQ + chunk * 32 + tt) * 16 + h] = bn; }
                }
            }
            if (late_on) { late_stash(late_sub, lv, lscr, lane); if (++late_sub == 4) { late_flush(ld_, lscr, lane); late_sub = 0; late_it += NPW; } }
            if (chunk >= 2) {
                const int yc = chunk - 2; const float* YBb = YB + (yc & 1) * 512;
                const int t2 = ptid >> 3, pr = ptid & 7; const f32x2 yy = *(const f32x2*)(YBb + t2 * 16 + 2 * pr);
                *(unsigned*)(YR + ((size_t)b * SEQ + yc * 32 + t2) * 1024 + h * 64 + quarter * 16 + 2 * pr) = pk2(yy.x, yy.y);
            }
            __syncthreads();
        }
        if (do_late) while (late_it < LATE_ITEMS) { if (late_sub == 0) ld_ = late_decode(a, late_it); late_load(ld_, late_sub, lv, lane); late_stash(late_sub, lv, lscr, lane); if (++late_sub == 4) { late_flush(ld_, lscr, lane); late_sub = 0; late_it += NPW; } }
        {   const int yc = 127; const float* YBb = YB + (yc & 1) * 512;
            const int t2 = ptid >> 3, pr = ptid & 7; const f32x2 yy = *(const f32x2*)(YBb + t2 * 16 + 2 * pr);
            *(unsigned*)(YR + ((size_t)b * SEQ + yc * 32 + t2) * 1024 + h * 64 + quarter * 16 + 2 * pr) = pk2(yy.x, yy.y); }
    } else {
        const int q = lane & 15, rloc = wid * 4 + (lane >> 4), irow = quarter * 16 + rloc;
        f32x2 S0 = (f32x2){0.f, 0.f}, S1 = (f32x2){0.f, 0.f};
        __syncthreads();
#pragma unroll 1
        for (int chunk = 0; chunk < 128; ++chunk) {
            const float* OPb = OP + (chunk & 1) * 10240; const float* VVb = VV + (chunk & 1) * 2048; const float* CCb = CC + (chunk & 1) * 64; float* YBb = YB + (chunk & 1) * 512;
#define RW_LD(o, s_) do { const float* op_ = OPb + (s_) * 320 + q * 20; o.nkk = *(const f32x4*)(op_); o.wr = *(const f32x4*)(op_ + 4); o.w = *(const f32x4*)(op_ + 8); o.kka = *(const f32x4*)(op_ + 12); o.k2 = *(const f32x4*)(op_ + 16); \
                o.vi = VVb[(s_) * 64 + irow]; o.cc = *(const f32x2*)(CCb + 2 * (s_)); } while (0)
#define RW_STEP(o, s_) do { const f32x2 p_ = S0 * o.nkk.lo + S1 * o.nkk.hi; const f32x2 r_ = S0 * o.wr.lo + S1 * o.wr.hi; \
                const f32x2 t0_ = S0 * o.w.lo + o.vi * o.k2.lo; const f32x2 t1_ = S1 * o.w.hi + o.vi * o.k2.hi; \
                float d1 = p_.x + p_.y, d2 = r_.x + r_.y; row16_sum2(d1, d2); \
                S0 = t0_ + d1 * o.kka.lo; S1 = t1_ + d1 * o.kka.hi; YBb[(s_) * 16 + rloc] = d2 + d1 * o.cc.x + o.vi * o.cc.y; } while (0)
            RwStep o0, o1, n0, n1;
            RW_LD(o0, 0); RW_LD(o1, 1);
#pragma unroll
            for (int s = 0; s < 32; s += 2) {
                if (s + 2 < 32) { RW_LD(n0, s + 2); RW_LD(n1, s + 3); }
                __builtin_amdgcn_sched_barrier(0);
                RW_STEP(o0, s); RW_STEP(o1, s + 1);
                __builtin_amdgcn_sched_barrier(0);
                o0 = n0; o1 = n1;
            }
#undef RW_LD
#undef RW_STEP
            __syncthreads();
        }
    }
    __syncthreads();
}

__device__ __forceinline__ void rwkv_post(const Args& a) {
    const int lane = threadIdx.x & 63, gw = blockIdx.x * 8 + (threadIdx.x >> 6), NGW = gridDim.x * 8;
    const bf16_t* U = (const bf16_t*)(a.ws + WS_U); const bf16_t* Gb = (const bf16_t*)(a.ws + WS_G); const float* BN = (const float*)(a.ws + WS_BN);
    const bf16_t* YR = (const bf16_t*)((unsigned char*)a.out + DO_YR); bf16_t* YM = (bf16_t*)(a.ws + WS_HN);
    const float* mu = a.in[10]; const float* lnw = a.in[19]; const float* lnb = a.in[20];
    const int cq = lane & 15;
#pragma unroll 2
    for (int pb = gw * 4; pb < T_TOK * 16; pb += NGW * 4) {
        const int pair = pb + (lane >> 4), t = pair >> 4, h = pair & 15, ch = h * 64 + 4 * cq;
        const u32x2 yr = __builtin_nontemporal_load((const u32x2*)(YR + (size_t)t * 1024 + ch));
        const float y[4] = {bflo(yr.x), bfhi(yr.x), bflo(yr.y), bfhi(yr.y)};
        const float mean = row16_sum((y[0] + y[1]) + (y[2] + y[3])) * (1.f / 64.f);
        float vs = 0.f;
#pragma unroll
        for (int j = 0; j < 4; ++j) vs += (y[j] - mean) * (y[j] - mean);
        const float rstd = rsqrtf(row16_sum(vs) * (1.f / 64.f) + 64e-5f);
        const bf16_t* uv = U + (size_t)t * NU + 4624 + ch;
        const u32x2 vcr = *(const u32x2*)uv; u32x2 vpr = (u32x2){0u, 0u}; if (t & (SEQ - 1)) vpr = *(const u32x2*)(uv - NU);
        const float vc[4] = {bflo(vcr.x), bfhi(vcr.x), bflo(vcr.y), bfhi(vcr.y)}, vp[4] = {bflo(vpr.x), bfhi(vpr.x), bflo(vpr.y), bfhi(vpr.y)};
        const u32x2 gr = __builtin_nontemporal_load((const u32x2*)(Gb + (size_t)t * 1024 + ch)); const float gt[4] = {bflo(gr.x), bfhi(gr.x), bflo(gr.y), bfhi(gr.y)};
        const float bn = BN[(size_t)t * 16 + h];
        float o[4];
#pragma unroll
        for (int j = 0; j < 4; ++j) { const float v = vc[j] + (vp[j] - vc[j]) * mu[2048 + ch + j]; o[j] = ((y[j] - mean) * rstd * lnw[ch + j] + lnb[ch + j] + bn * v) * gt[j]; }
        u32x2 w; w.x = pk2(o[0], o[1]); w.y = pk2(o[2], o[3]);
        *(u32x2*)(YM + (size_t)t * DM + 1024 + ch) = w;
    }
}

__device__ __forceinline__ void attn_item(const Args& a, unsigned char* lds, int item) {
    const int tid = threadIdx.x, lane = tid & 63, wid = tid >> 6, fr = lane & 15, fq = lane >> 4;
    const int qt = item & 31, hd = (item >> 5) & 3, b = item >> 7;
    const int t0 = b * SEQ + qt * 128;
    const bf16_t* Q = (const bf16_t*)(a.ws + WS_U); bf16_t* Ob = (bf16_t*)(a.ws + WS_HN); const bf16_t* Kx = (const bf16_t*)(a.ws + WS_KX); const bf16_t* Vt = (const bf16_t*)(a.ws + WS_VT);
    bf16_t* Qs = (bf16_t*)lds; bf16_t* Ks = Qs + 128 * 72; bf16_t* Vs = (bf16_t*)lds; bf16_t* Ps = (bf16_t*)(lds + 55296);
    f32x4 s[16];
#pragma unroll
    for (int f = 0; f < 16; ++f) s[f] = (f32x4){0.f, 0.f, 0.f, 0.f};
    u32x4 qr[2], kr[4];
#define AT_LOADQK(dc_) do { _Pragma("unroll") for (int i_ = 0; i_ < 2; ++i_) { const int idx = tid + 512 * i_, r = idx >> 3, ch = idx & 7; qr[i_] = __builtin_nontemporal_load((const u32x4*)(Q + (size_t)(t0 + r) * DM + hd * 512 + (dc_) * 64 + ch * 8)); } \
        _Pragma("unroll") for (int i_ = 0; i_ < 4; ++i_) { const int idx = tid + 512 * i_, r = idx >> 3, ch = idx & 7; kr[i_] = *(const u32x4*)(Kx + (size_t)(b * 256 + r) * DM + hd * 512 + (dc_) * 64 + ch * 8); } } while (0)
    AT_LOADQK(0);
#pragma unroll 1
    for (int dc = 0; dc < 8; ++dc) {
#pragma unroll
        for (int i_ = 0; i_ < 2; ++i_) { const int idx = tid + 512 * i_, r = idx >> 3, ch = idx & 7; *(u32x4*)(Qs + r * 72 + ch * 8) = qr[i_]; }
#pragma unroll
        for (int i_ = 0; i_ < 4; ++i_) { const int idx = tid + 512 * i_, r = idx >> 3, ch = idx & 7; *(u32x4*)(Ks + r * 72 + ch * 8) = kr[i_]; }
        __syncthreads();
        if (dc + 1 < 8) AT_LOADQK(dc + 1);
        wave_mma<16, 64, false>(s, Qs + (16 * wid) * 72, 72, Ks, 72, fr, fq);
        __syncthreads();
    }
#undef AT_LOADQK
    u32x4 vr[4];
#define AT_LOADV(dc_) do { _Pragma("unroll") for (int i_ = 0; i_ < 4; ++i_) { const int idx = tid + 512 * i_, r = idx >> 5, ch = idx & 31; vr[i_] = *(const u32x4*)(Vt + (size_t)(hd * 512 + (dc_) * 64 + r) * 1024 + b * 256 + ch * 8); } } while (0)
    AT_LOADV(0);
    const float scale = 0.04419417382415922f;
#pragma unroll
    for (int j = 0; j < 4; ++j) {
        float mx = s[0][j];
#pragma unroll
        for (int f = 1; f < 16; ++f) mx = fmaxf(mx, s[f][j]);
        mx = row16_max(mx);
        float sum = 0.f;
#pragma unroll
        for (int f = 0; f < 16; ++f) { const float p = __expf((s[f][j] - mx) * scale); s[f][j] = p; sum += p; }
        sum = row16_sum(sum);
        const float inv = __builtin_amdgcn_rcpf(sum);
#pragma unroll
        for (int f = 0; f < 16; ++f) Ps[(16 * wid + 4 * fq + j) * 264 + 16 * f + fr] = f2bf(s[f][j] * inv);
    }
#pragma unroll 1
    for (int dc = 0; dc < 8; ++dc) {
        __syncthreads();
#pragma unroll
        for (int i_ = 0; i_ < 4; ++i_) { const int idx = tid + 512 * i_, r = idx >> 5, ch = idx & 31; *(u32x4*)(Vs + r * 264 + ch * 8) = vr[i_]; }
        __syncthreads();
        if (dc + 1 < 8) AT_LOADV(dc + 1);
        f32x4 o[4];
#pragma unroll
        for (int f = 0; f < 4; ++f) o[f] = (f32x4){0.f, 0.f, 0.f, 0.f};
        wave_mma<4, 256, true>(o, Ps + (16 * wid) * 264, 264, Vs, 264, fr, fq);
#pragma unroll
        for (int f = 0; f < 4; ++f) { u32x2 w; w.x = pk2(o[f][0], o[f][1]); w.y = pk2(o[f][2], o[f][3]);
            *(u32x2*)(Ob + (size_t)(t0 + 16 * wid + fr) * DM + hd * 512 + dc * 64 + 16 * f + 4 * fq) = w; }
    }
#undef AT_LOADV
    __syncthreads();
}


#define XB_TMO      128
#define XB_XCNT(j)  (256  + 64 * (j))
#define XB_XSUB(j)  (1280 + 64 * (j))
#define XB_XGEN(j)  (2304 + 64 * (j))
#define XB_TOP      3328
#define XB_TOPGEN   3392
#define XCD_BAR_WORDS 3456
#define XB_SPIN_CAP (1u << 18)
__device__ __forceinline__ unsigned xb_ld(unsigned* p)              { return __hip_atomic_load(p, __ATOMIC_RELAXED, __HIP_MEMORY_SCOPE_AGENT); }
__device__ __forceinline__ unsigned xb_add(unsigned* p, unsigned v) { return __hip_atomic_fetch_add(p, v, __ATOMIC_RELAXED, __HIP_MEMORY_SCOPE_AGENT); }
__device__ __forceinline__ unsigned xb_xcc_id() { return (unsigned)__builtin_amdgcn_s_getreg((3 << 11) | 20) & 0xFu; }
#define XB_SPIN(cond, bar) do { unsigned _sp = 0; while (cond) { __builtin_amdgcn_s_sleep(1); \
    if ((++_sp & 255u) == 0u) { if (xb_ld(&(bar)[XB_TMO])) break; if (_sp > XB_SPIN_CAP) { atomicAdd(&(bar)[XB_TMO], 1u); break; } } } } while (0)
struct XcdBarrier { unsigned* bar; unsigned x; volatile LAS unsigned* st; };
__device__ __forceinline__ XcdBarrier xcd_barrier_post(unsigned* bar, volatile LAS unsigned* st) {
    XcdBarrier b; b.bar = bar; b.x = xb_xcc_id(); b.st = st;
    if (threadIdx.x == 0) (void)xb_add(&bar[XB_XCNT(b.x)], 1u);
    return b;
}
__device__ __forceinline__ void xcd_barrier_complete(unsigned* bar, unsigned x, unsigned& nloc, unsigned& nx) {
    const unsigned G = gridDim.x * gridDim.y * gridDim.z;
    unsigned sum, cnt, mine, sp = 0u;
    for (;;) {
        sum = 0u; cnt = 0u; mine = 0u;
#pragma unroll
        for (unsigned j = 0; j < 16; ++j) { const unsigned c = xb_ld(&bar[XB_XCNT(j)]); sum += c; cnt += (c > 0u) ? 1u : 0u; mine = (j == x) ? c : mine; }
        if (sum == G) break;
        __builtin_amdgcn_s_sleep(1);
        if ((++sp & 255u) == 0u) { if (xb_ld(&bar[XB_TMO])) break; if (sp > XB_SPIN_CAP) { atomicAdd(&bar[XB_TMO], 1u); break; } }
    }
    nloc = mine > 0u ? mine : 1u; nx = cnt > 0u ? cnt : 1u;
}
__device__ __forceinline__ void xcd_barrier(const XcdBarrier& b) {
    asm volatile("s_waitcnt vmcnt(0)" ::: "memory");
    __syncthreads();
    if (threadIdx.x == 0) {
        unsigned* bar = b.bar;
        __builtin_amdgcn_s_waitcnt(0);
        unsigned nloc = b.st[0], nx = b.st[1];
        if (nloc == 0u) { xcd_barrier_complete(bar, b.x, nloc, nx); b.st[0] = nloc; b.st[1] = nx; }
        const unsigned old = xb_add(&bar[XB_XSUB(b.x)], 1u);
        const unsigned gen = old / nloc;
        if (old + 1u == (gen + 1u) * nloc) {
            __builtin_amdgcn_fence(__ATOMIC_RELEASE, "agent");
            asm volatile("s_waitcnt vmcnt(0)" ::: "memory");
            const unsigned og = xb_add(&bar[XB_TOP], 1u);
            const unsigned tg = og / nx;
            if (og + 1u == (tg + 1u) * nx) xb_add(&bar[XB_TOPGEN], 1u);
            else XB_SPIN(xb_ld(&bar[XB_TOPGEN]) == tg, bar);
            __builtin_amdgcn_fence(__ATOMIC_ACQUIRE, "agent");
            xb_add(&bar[XB_XGEN(b.x)], 1u);
            asm volatile("s_waitcnt vmcnt(0)" ::: "memory");
        } else {
            XB_SPIN(xb_ld(&bar[XB_XGEN(b.x)]) == gen, bar);
            __builtin_amdgcn_fence(__ATOMIC_ACQUIRE, "agent");
            asm volatile("s_waitcnt vmcnt(0)" ::: "memory");
        }
    }
    __syncthreads();
}

constexpr int NPHASE = 14;
#ifndef REP_PH
#define REP_PH -1
#endif
#define NREP(k) ((k) == REP_PH ? 2 : 1)
__global__ void __launch_bounds__(512, 2) hymba_fwd(Args a) {
    extern __shared__ __attribute__((aligned(16))) unsigned char lds[];
    cg::grid_group grid = cg::this_grid();
    unsigned char* ws = a.ws;
    const int G = gridDim.x, bid = blockIdx.x;
    volatile LAS unsigned* xst = (volatile LAS unsigned*)((LAS unsigned char*)lds + 139264);
    if (threadIdx.x < 2) xst[threadIdx.x] = 0u;
    __syncthreads();
    const int vb = (G % 8 == 0) ? (bid % 8) * (G / 8) + bid / 8 : bid;
    const XcdBarrier xbar = xcd_barrier_post((unsigned*)(a.ws + WS_BAR), xst);
    if (a.ph_hi < 0) grid.sync();
#define IN(k) (a.ph_lo <= (k) && (k) < a.ph_hi)
#define SEAM(k) do { if (a.ph_lo <= (k) && (k) + 1 < a.ph_hi) xcd_barrier(xbar); } while (0)
    bf16_t* HN = (bf16_t*)(ws + WS_HN); bf16_t* Ub = (bf16_t*)(ws + WS_U);
    if (IN(0)) for (int rp_ = 0; rp_ < NREP(0); ++rp_) p0_prologue(a, lds);
    SEAM(0);
    if (IN(1)) for (int rp_ = 0; rp_ < NREP(1); ++rp_) run_gemm(lds, HN, (const bf16_t*)(ws + WS_WIN), T_TOK, NU, DM, pg8::EpiBf16{Ub, NU, 0, nullptr});
    SEAM(1);
    if (IN(2)) for (int rp_ = 0; rp_ < NREP(2); ++rp_) { lora_prep(a); for (int it = vb; it < 256; it += G) ssd_passA(a, lds, it); }
    SEAM(2);
    if (IN(3)) {
        const pg8::EpiLora EL{(bf16_t*)(ws + WS_E), (bf16_t*)(ws + WS_A), (bf16_t*)(ws + WS_G), a.in[11], a.in[13]};
        const bf16_t* LAp = (const bf16_t*)((unsigned char*)a.out + DO_LA);
        if (G == 256) {
            if (bid < 32) run_gemm(lds, (const bf16_t*)(ws + WS_MN), (const bf16_t*)(ws + WS_WK), 1024, DM, DM, pg8::EpiBf16{(bf16_t*)(ws + WS_KX), DM, 0, nullptr}, 32, bid);
            else if (bid < 64) run_gemm(lds, (const bf16_t*)(ws + WS_WV), (const bf16_t*)(ws + WS_MN), DM, 1024, DM, pg8::EpiBf16{(bf16_t*)(ws + WS_VT), 1024, 0, nullptr}, 32, bid - 32);
            else run_gemm(lds, LAp, (const bf16_t*)(ws + WS_LORA), T_TOK, 3072, 512, EL, 192, bid - 64);
        } else {
            run_gemm(lds, (const bf16_t*)(ws + WS_MN), (const bf16_t*)(ws + WS_WK), 1024, DM, DM, pg8::EpiBf16{(bf16_t*)(ws + WS_KX), DM, 0, nullptr});
            run_gemm(lds, (const bf16_t*)(ws + WS_WV), (const bf16_t*)(ws + WS_MN), DM, 1024, DM, pg8::EpiBf16{(bf16_t*)(ws + WS_VT), 1024, 0, nullptr});
            run_gemm(lds, LAp, (const bf16_t*)(ws + WS_LORA), T_TOK, 3072, 512, EL);
        }
        ssd_state_scan(a);
    }
    SEAM(3);
    if (IN(4)) for (int rp_ = 0; rp_ < NREP(4); ++rp_) {
        for (int r2 = 0; r2 < NREP(41); ++r2) for (int it = vb; it < 256; it += G) ssd_passC(a, lds, it);
        for (int r2 = 0; r2 < NREP(42); ++r2) for (int it = vb; it < 256; it += G) rwkv_scan(a, lds, it, it == vb);
    }
    SEAM(4);
    if (IN(5)) for (int rp_ = 0; rp_ < NREP(5); ++rp_) rwkv_post(a);
    SEAM(5);
    bf16_t* Xb = (bf16_t*)(ws + WS_E);
    bf16_t* Fb = (bf16_t*)(ws + WS_HN);
    float* SS1 = (float*)(ws + WS_SS); float* SS2 = SS1 + T_TOK; float* SS3 = SS2 + T_TOK;
    if (IN(6)) for (int rp_ = 0; rp_ < NREP(6); ++rp_) run_gemm(lds, HN, (const bf16_t*)(ws + WS_WOUT), T_TOK, DM, DM, pg8::EpiResBf16<false>{a.in[0], Xb, DM, SS1});
    SEAM(6);
    if (IN(8)) for (int rp_ = 0; rp_ < NREP(8); ++rp_) run_gemm(lds, Xb, (const bf16_t*)(ws + WS_WQ), T_TOK, DM, DM, pg8::EpiBf16{Ub, DM, 0, SS1});
    SEAM(8);
    if (IN(9)) for (int rp_ = 0; rp_ < NREP(9); ++rp_) for (int it = vb; it < 512; it += G) attn_item(a, lds, it);
    SEAM(9);
    if (IN(10)) run_gemm(lds, HN, (const bf16_t*)(ws + WS_WO), T_TOK, DM, DM, pg8::EpiResBf16<true>{Xb, Xb, DM, SS2});
    SEAM(10);
    if (IN(12)) for (int rp_ = 0; rp_ < NREP(12); ++rp_) run_gemm(lds, Xb, (const bf16_t*)(ws + WS_W1), T_TOK, DFF, DM, pg8::EpiBf16{Fb, DFF, 1, SS2});
    SEAM(12);
    if (IN(13)) run_gemm(lds, Fb, (const bf16_t*)(ws + WS_W2), T_TOK, DM, DFF, pg8::EpiResBf16<true>{Xb, Xb, DM, SS3});
    SEAM(13);
    if (IN(14)) { const f32x4* g4 = (const f32x4*)a.in[31];
#pragma unroll 4
        for (int idx = bid * 512 + threadIdx.x; idx < T_TOK * 256; idx += G * 512) {
            const int row = idx >> 8, c8 = idx & 255; const float rs = rsqrtf(SS3[row] * (1.f / 2048.f) + 1e-6f);
            const u32x4 r = __builtin_nontemporal_load((const u32x4*)(Xb + (size_t)row * DM + c8 * 8)); const f32x4 ga = g4[c8 * 2], gb = g4[c8 * 2 + 1];
            f32x4 o0 = (f32x4){bflo(r.x), bfhi(r.x), bflo(r.y), bfhi(r.y)}, o1 = (f32x4){bflo(r.z), bfhi(r.z), bflo(r.w), bfhi(r.w)};
            o0 = o0 * rs * ga; o1 = o1 * rs * gb;
            f32x4* op = (f32x4*)(a.out + (size_t)row * DM + c8 * 8); __builtin_nontemporal_store(o0, op); __builtin_nontemporal_store(o1, op + 1); } }
#undef IN
#undef SEAM
}

extern "C" void kernel_launch(void* const* d_in, const int* in_sizes, int n_in, void* d_out, int out_size, void* d_ws, size_t ws_size, hipStream_t stream) {
    static int grid = 0;
    if (grid == 0) {
        if (n_in != 32 || out_size != T_TOK * DM || ws_size < WS_END) { fprintf(stderr, "kernel_launch: unexpected shapes (n_in %d out %d ws %zu)\n", n_in, out_size, ws_size); grid = -1; return; }
        int dev = 0, cus = 0, per_cu = 0;
        (void)hipGetDevice(&dev); (void)hipDeviceGetAttribute(&cus, hipDeviceAttributeMultiprocessorCount, dev);
        if (hipFuncSetAttribute((const void*)hymba_fwd, hipFuncAttributeMaxDynamicSharedMemorySize, LDS_BYTES) != hipSuccess) { fprintf(stderr, "kernel_launch: hipFuncSetAttribute failed\n"); grid = -1; return; }
        if (hipOccupancyMaxActiveBlocksPerMultiprocessor(&per_cu, (const void*)hymba_fwd, 512, LDS_BYTES) != hipSuccess || per_cu < 1) per_cu = 1;
        (void)hipGetLastError();
        grid = cus * 1;
        if (grid <= 0) grid = 256;
    }
    if (grid < 0) return;
    (void)hipMemsetAsync((char*)d_ws + WS_BAR, 0, XCD_BAR_WORDS * 4, stream);
    Args a{};
    for (int i = 0; i < 32; ++i) a.in[i] = (const float*)d_in[i];
    a.out = (float*)d_out; a.ws = (unsigned char*)d_ws; a.ph_lo = 0; a.ph_hi = NPHASE + 1;
    void* args[] = {&a};
    hipError_t e = hipLaunchCooperativeKernel((const void*)hymba_fwd, dim3(grid), dim3(512), args, LDS_BYTES, stream);
    if (e != hipSuccess) fprintf(stderr, "kernel_launch: cooperative launch failed: %s (grid %d)\n", hipGetErrorString(e), grid);
}
```

```cpp
#include <hip/hip_runtime.h>
#include <hip/hip_cooperative_groups.h>
#include <cstdio>
namespace cg = cooperative_groups;

typedef unsigned short bf16_t;
typedef short bf16x8 __attribute__((ext_vector_type(8)));
typedef float f32x4 __attribute__((ext_vector_type(4)));
typedef float f32x2 __attribute__((ext_vector_type(2)));
typedef unsigned u32x4 __attribute__((ext_vector_type(4)));
typedef unsigned u32x2 __attribute__((ext_vector_type(2)));
#define LAS __attribute__((address_space(3)))

constexpr int T_TOK = 16384, SEQ = 4096, DM = 2048, NU = 6144, DFF = 8192;
constexpr int LDS_BYTES = 140 * 1024;
constexpr size_t MiB = 1u << 20;
constexpr size_t WS_WIN = 0, WS_WOUT = 24 * MiB, WS_WQ = 32 * MiB, WS_WK = 40 * MiB, WS_WV = 48 * MiB, WS_WO = 56 * MiB, WS_W1 = 64 * MiB, WS_W2 = 96 * MiB,
                 WS_LORA = 128 * MiB, WS_MN = 132 * MiB, WS_KX = 136 * MiB, WS_VT = 140 * MiB, WS_HN = 144 * MiB, WS_U = 208 * MiB,
                 WS_E = 400 * MiB, WS_A = 432 * MiB, WS_G = 464 * MiB, WS_BN = 496 * MiB, WS_CD = 497 * MiB, WS_BAR = 498 * MiB, WS_SS = 499 * MiB, WS_END = 500 * MiB;
constexpr size_t DO_ST = 0, DO_XC = 32 * MiB, DO_DT = 80 * MiB, DO_CS = 81 * MiB, DO_LA = 82 * MiB, DO_YR = 82 * MiB;

struct Args { const float* in[32]; float* out; unsigned char* ws; int ph_lo, ph_hi; };

__device__ __forceinline__ float bf2f(unsigned v) { return __uint_as_float(v << 16); }
__device__ __forceinline__ float bflo(unsigned v) { return __uint_as_float(v << 16); }
__device__ __forceinline__ float bfhi(unsigned v) { return __uint_as_float(v & 0xffff0000u); }
typedef __bf16 bf16x2_t __attribute__((ext_vector_type(2)));
__device__ __forceinline__ unsigned pk2(float lo, float hi) { bf16x2_t v = {(__bf16)lo, (__bf16)hi}; return __builtin_bit_cast(unsigned, v); }
__device__ __forceinline__ bf16_t f2bf(float f) { return (bf16_t)(pk2(f, 0.f) & 0xffffu); }
__device__ __forceinline__ float wave_sum(float v) {
#pragma unroll
    for (int o = 1; o < 64; o <<= 1) v += __shfl_xor(v, o);
    return v;
}
template <int CTRL> __device__ __forceinline__ float dppf(float x) { return __builtin_bit_cast(float, __builtin_amdgcn_update_dpp(0, __builtin_bit_cast(int, x), CTRL, 0xF, 0xF, true)); }
__device__ __forceinline__ float row16_sum(float x) { x += dppf<0xB1>(x); x += dppf<0x4E>(x); x += dppf<0x141>(x); x += dppf<0x140>(x); return x; }
__device__ __forceinline__ void row16_sum2(float& x, float& y) {
    x += dppf<0xB1>(x); y += dppf<0xB1>(y); x += dppf<0x4E>(x); y += dppf<0x4E>(y); x += dppf<0x141>(x); y += dppf<0x141>(y); x += dppf<0x140>(x); y += dppf<0x140>(y);
}
__device__ __forceinline__ float row16_max(float x) { x = fmaxf(x, dppf<0xB1>(x)); x = fmaxf(x, dppf<0x4E>(x)); x = fmaxf(x, dppf<0x141>(x)); x = fmaxf(x, dppf<0x140>(x)); return x; }
__device__ __forceinline__ float softplusf(float x) { return fmaxf(x, 0.f) + __logf(1.f + __expf(-fabsf(x))); }
__device__ __forceinline__ float sigmoidf_(float x) { return 1.f / (1.f + __expf(-x)); }
__device__ __forceinline__ float siluf_(float x) { return x / (1.f + __expf(-x)); }
__device__ __forceinline__ f32x4 mfma16(bf16x8 a, bf16x8 b, f32x4 c) { return __builtin_amdgcn_mfma_f32_16x16x32_bf16(a, b, c, 0, 0, 0); }

template <int NF, int KT, bool TRANS>
__device__ __forceinline__ void wave_mma(f32x4 (&acc)[NF], const bf16_t* A, int sa, const bf16_t* B, int sb, int fr, int fq) {
#pragma unroll
    for (int k = 0; k < KT; k += 32) {
        const bf16x8 av = *(const bf16x8*)(A + fr * sa + k + 8 * fq);
#pragma unroll
        for (int f = 0; f < NF; ++f) {
            const bf16x8 bv = *(const bf16x8*)(B + (16 * f + fr) * sb + k + 8 * fq);
            acc[f] = TRANS ? mfma16(bv, av, acc[f]) : mfma16(av, bv, acc[f]);
        }
    }
}

namespace pg8 {
constexpr int BM = 256, BK = 64, HALF = 128, HTB = HALF * BK * 2, STAGE_BYTES = 8 * HTB, NXCD = 8, WGM = 4;
__device__ __forceinline__ int lds_byte(int r, int c) { const int st = (r >> 4) * 2 + (c >> 5), rr = r & 15, cc = c & 31, ob = rr * 64 + cc * 2; return st * 1024 + (ob ^ (((ob >> 9) & 1) << 5)); }
__device__ __forceinline__ void stage_rc(int b, int& R, int& C) { const int st = b / 1024, sb = b % 1024, swz = sb ^ (((sb >> 9) & 1) << 5); R = (st >> 1) * 16 + swz / 64; C = (st & 1) * 32 + (swz % 64) / 2; }
__device__ __forceinline__ int perm32(int rho) { const int n = rho >> 4, i = rho & 15; return 8 * (i >> 2) + 4 * n + (i & 3); }
struct Unit { int pm, pn; };
struct Gemm { const bf16_t* A; const bf16_t* Bt; int M, N, K; };
struct StaticOrder {
    int nM, nN, nwg, G, c;
    __device__ void init(int M, int N, int G_, int c_) { nM = M / BM; nN = N / BM; nwg = nM * nN; G = G_; c = c_; }
    __device__ bool next(int i, Unit& u) const {
        const long L = (long)i * G + c; if (L >= nwg) return false;
        int wgid = (int)L; { const int q = nwg / NXCD, r = nwg % NXCD, xcd = wgid % NXCD, off = wgid / NXCD; wgid = (xcd < r ? xcd * (q + 1) : r * (q + 1) + (xcd - r) * q) + off; }
        const int nig = WGM * nN, gid = wgid / nig, fm = gid * WGM, gsz = (nM - fm) < WGM ? (nM - fm) : WGM;
        u.pm = fm + ((wgid % nig) % gsz); u.pn = (wgid % nig) / gsz; return true;
    }
};
struct EpiBf16 {
    static constexpr bool PERM = true;
    bf16_t* O; int ldc; int act; const float* ss;
    __device__ __forceinline__ void operator()(const f32x4 (&acc)[2][2][4][2], const Unit& u, int wr, int wc, int fr, int fq) const {
        const int row0 = u.pm * BM + wr * 64 + fr, col0 = u.pn * BM + wc * 32 + 8 * fq;
#pragma unroll
        for (int ai = 0; ai < 2; ++ai)
#pragma unroll
            for (int m = 0; m < 4; ++m) { const int row = row0 + ai * HALF + m * 16; bf16_t* rowp = O + (size_t)row * ldc + col0;
                const float rs = ss ? rsqrtf(ss[row] * (1.f / 2048.f) + 1e-6f) : 1.f;
#pragma unroll
                for (int bj = 0; bj < 2; ++bj) { f32x4 v0 = acc[ai][bj][m][0] * rs, v1 = acc[ai][bj][m][1] * rs;
                    if (act == 1) {
#pragma unroll
                        for (int j = 0; j < 4; ++j) { const float a0 = fmaxf(v0[j], 0.f), a1 = fmaxf(v1[j], 0.f); v0[j] = a0 * a0; v1[j] = a1 * a1; } }
                    u32x4 w; w.x = pk2(v0[0], v0[1]); w.y = pk2(v0[2], v0[3]); w.z = pk2(v1[0], v1[1]); w.w = pk2(v1[2], v1[3]);
                    *(u32x4*)(rowp + bj * HALF) = w; } }
    }
};
template <bool BASE_BF16> struct EpiResBf16 {
    static constexpr bool PERM = true;
    const void* base; bf16_t* out; int ldc; float* ss;
    __device__ __forceinline__ void operator()(const f32x4 (&acc)[2][2][4][2], const Unit& u, int wr, int wc, int fr, int fq) const {
        const int row0 = u.pm * BM + wr * 64 + fr, col0 = u.pn * BM + wc * 32 + 8 * fq;
#pragma unroll
        for (int ai = 0; ai < 2; ++ai)
#pragma unroll
            for (int m = 0; m < 4; ++m) { const int row = row0 + ai * HALF + m * 16; const size_t off = (size_t)row * ldc + col0; float sq = 0.f;
#pragma unroll
                for (int bj = 0; bj < 2; ++bj) { f32x4 b0, b1;
                    if (BASE_BF16) { const u32x4 r = *(const u32x4*)((const bf16_t*)base + off + bj * HALF); b0 = (f32x4){bflo(r.x), bfhi(r.x), bflo(r.y), bfhi(r.y)}; b1 = (f32x4){bflo(r.z), bfhi(r.z), bflo(r.w), bfhi(r.w)}; }
                    else { b0 = __builtin_nontemporal_load((const f32x4*)((const float*)base + off + bj * HALF)); b1 = __builtin_nontemporal_load((const f32x4*)((const float*)base + off + bj * HALF + 4)); }
                    const f32x4 v0 = b0 + acc[ai][bj][m][0], v1 = b1 + acc[ai][bj][m][1];
                    sq += (v0[0] * v0[0] + v0[1] * v0[1]) + (v0[2] * v0[2] + v0[3] * v0[3]) + (v1[0] * v1[0] + v1[1] * v1[1]) + (v1[2] * v1[2] + v1[3] * v1[3]);
                    u32x4 w; w.x = pk2(v0[0], v0[1]); w.y = pk2(v0[2], v0[3]); w.z = pk2(v1[0], v1[1]); w.w = pk2(v1[2], v1[3]);
                    *(u32x4*)(out + off + bj * HALF) = w; }
                sq += __shfl_xor(sq, 16); sq += __shfl_xor(sq, 32);
                if (fq == 0) atomicAdd(ss + row, sq); }
    }
};
struct EpiResF32 {
    static constexpr bool PERM = true;
    const bf16_t* base; float* out; int ldc;
    __device__ __forceinline__ void operator()(const f32x4 (&acc)[2][2][4][2], const Unit& u, int wr, int wc, int fr, int fq) const {
        const int row0 = u.pm * BM + wr * 64 + fr, col0 = u.pn * BM + wc * 32 + 8 * fq;
#pragma unroll
        for (int ai = 0; ai < 2; ++ai)
#pragma unroll
            for (int m = 0; m < 4; ++m) { const size_t off = (size_t)(row0 + ai * HALF + m * 16) * ldc + col0;
#pragma unroll
                for (int bj = 0; bj < 2; ++bj) { const u32x4 r = *(const u32x4*)(base + off + bj * HALF);
                    const f32x4 b0 = (f32x4){bflo(r.x), bfhi(r.x), bflo(r.y), bfhi(r.y)}, b1 = (f32x4){bflo(r.z), bfhi(r.z), bflo(r.w), bfhi(r.w)};
                    *(f32x4*)(out + off + bj * HALF) = b0 + acc[ai][bj][m][0]; *(f32x4*)(out + off + bj * HALF + 4) = b1 + acc[ai][bj][m][1]; } }
    }
};
struct EpiLora {
    static constexpr bool PERM = true;
    bf16_t *E, *A, *G; const float *w0, *a0;
    template <int GRP>
    __device__ __forceinline__ void store(const f32x4 (&acc)[2][2][4][2], bf16_t* O, const float* bp, int row0, int col0) const {
        f32x4 bv[2][2];
#pragma unroll
        for (int bj = 0; bj < 2; ++bj)
#pragma unroll
            for (int n = 0; n < 2; ++n) bv[bj][n] = GRP == 2 ? (f32x4){0.f, 0.f, 0.f, 0.f} : *(const f32x4*)(bp + col0 + bj * HALF + 4 * n);
#pragma unroll
        for (int ai = 0; ai < 2; ++ai)
#pragma unroll
            for (int m = 0; m < 4; ++m) { bf16_t* rowp = O + (size_t)(row0 + ai * HALF + m * 16) * 1024 + col0;
#pragma unroll
                for (int bj = 0; bj < 2; ++bj) { f32x4 v0 = acc[ai][bj][m][0] + bv[bj][0], v1 = acc[ai][bj][m][1] + bv[bj][1];
                    if (GRP == 0) {
#pragma unroll
                        for (int j = 0; j < 4; ++j) { v0[j] = __expf(-softplusf(-v0[j]) - 0.5f); v1[j] = __expf(-softplusf(-v1[j]) - 0.5f); }
                    } else if (GRP == 1) {
#pragma unroll
                        for (int j = 0; j < 4; ++j) { v0[j] = sigmoidf_(v0[j]); v1[j] = sigmoidf_(v1[j]); }
                    }
                    u32x4 w; w.x = pk2(v0[0], v0[1]); w.y = pk2(v0[2], v0[3]); w.z = pk2(v1[0], v1[1]); w.w = pk2(v1[2], v1[3]);
                    *(u32x4*)(rowp + bj * HALF) = w; } }
    }
    __device__ __forceinline__ void operator()(const f32x4 (&acc)[2][2][4][2], const Unit& u, int wr, int wc, int fr, int fq) const {
        const int grp = u.pn >> 2;
        const int row0 = u.pm * BM + wr * 64 + fr, col0 = (u.pn & 3) * BM + wc * 32 + 8 * fq;
        if (grp == 0) store<0>(acc, E, w0, row0, col0);
        else if (grp == 1) store<1>(acc, A, a0, row0, col0);
        else store<2>(acc, G, a0, row0, col0);
    }
};

template <class Epi>
__device__ __forceinline__ void gemm_phase(LAS unsigned char* lds, const Gemm g, const StaticOrder& S, const Epi& E) {
    const int tid = threadIdx.x, wid = __builtin_amdgcn_readfirstlane(tid >> 6), lane = tid & 63, wr = wid >> 2, wc = wid & 3, fr = lane & 15, fq = lane >> 4;
    const int K = g.K, nt = K / BK;
    unsigned voffA[2], voffB[2];
#pragma unroll
    for (int i = 0; i < 2; ++i) { int R, C; stage_rc(tid * 16 + i * 8192, R, C); const int Rb = Epi::PERM ? ((R & ~31) + perm32(R & 31)) : R;
        voffA[i] = (unsigned)(R * K + C) * 2u; voffB[i] = (unsigned)(Rb * K + C) * 2u; }
    const size_t kstep = (size_t)(BK * 2);
    const size_t hstep = (size_t)HALF * K * 2;
    const size_t tstep = 2 * hstep;
    const unsigned ldsw = (unsigned)wid * 1024u;
    const int aoff = lds_byte(wr * 64 + fr, fq * 8), boff = lds_byte(wc * 32 + fr, fq * 8);
#define PG8_SA(b, h) (((b) * 2 + (h)) * HTB)
#define PG8_SB(b, h) ((4 + (b) * 2 + (h)) * HTB)
#define PG8_STAGE(bufoff, gbase, voff) do { _Pragma("unroll") for (int _i = 0; _i < 2; ++_i) \
        __builtin_amdgcn_global_load_lds((const unsigned*)((const char*)(gbase) + (voff)[_i]), (LAS unsigned*)(lds + (bufoff) + ldsw + _i * 8192), 16, 0, 0); } while (0)
#define PG8_LDA(dst, b, h) do { _Pragma("unroll") for (int m = 0; m < 4; ++m) _Pragma("unroll") for (int k = 0; k < 2; ++k) dst[m][k] = *(const LAS bf16x8*)(lds + PG8_SA(b, h) + aoff + m * 2048 + k * 1024); } while (0)
#define PG8_LDB(dst, b, h) do { _Pragma("unroll") for (int n = 0; n < 2; ++n) _Pragma("unroll") for (int k = 0; k < 2; ++k) dst[n][k] = *(const LAS bf16x8*)(lds + PG8_SB(b, h) + boff + n * 2048 + k * 1024); } while (0)
#define PG8_MMA(ai, bj, At, Bt) do { __builtin_amdgcn_s_setprio(1); _Pragma("unroll") for (int m = 0; m < 4; ++m) _Pragma("unroll") for (int n = 0; n < 2; ++n) _Pragma("unroll") for (int k = 0; k < 2; ++k) \
        acc[ai][bj][m][n] = __builtin_amdgcn_mfma_f32_16x16x32_bf16(Bt[n][k], At[m][k], acc[ai][bj][m][n], 0, 0, 0); __builtin_amdgcn_s_setprio(0); } while (0)
#define PG8_WAIT_V(n) asm volatile("s_waitcnt vmcnt(" #n ")" ::: "memory")
#define PG8_WAIT_L(n) asm volatile("s_waitcnt lgkmcnt(" #n ")" ::: "memory")
#define PG8_BAR __builtin_amdgcn_s_barrier()
#define PG8_SCHED __builtin_amdgcn_sched_barrier(0)
    Unit cur, nxt; int ui = 0;
    if (!S.next(0, cur)) return;
    f32x4 acc[2][2][4][2];
#pragma unroll
    for (int a = 0; a < 2; ++a)
#pragma unroll
        for (int b = 0; b < 2; ++b)
#pragma unroll
            for (int m = 0; m < 4; ++m)
#pragma unroll
                for (int n = 0; n < 2; ++n) acc[a][b][m][n] = (f32x4){0.f, 0.f, 0.f, 0.f};
    bf16x8 At[4][2], B0[2][2], B1[2][2];
    const char* cA = (const char*)g.A + (size_t)cur.pm * tstep; const char* cB = (const char*)g.Bt + (size_t)cur.pn * tstep;
    PG8_STAGE(PG8_SB(0, 0), cB, voffB); PG8_STAGE(PG8_SA(0, 0), cA, voffA); PG8_STAGE(PG8_SB(0, 1), cB + hstep, voffB); PG8_STAGE(PG8_SA(0, 1), cA + hstep, voffA);
    if (wr == 1) PG8_BAR;
    PG8_WAIT_V(4); PG8_BAR;
    PG8_STAGE(PG8_SB(1, 0), cB + kstep, voffB); PG8_STAGE(PG8_SA(1, 0), cA + kstep, voffA); PG8_STAGE(PG8_SB(1, 1), cB + hstep + kstep, voffB);
    PG8_WAIT_V(6); PG8_BAR;
    for (;;) {
        const bool has_next = S.next(ui + 1, nxt);
        const char* nA = has_next ? (const char*)g.A + (size_t)nxt.pm * tstep : cA; const char* nB = has_next ? (const char*)g.Bt + (size_t)nxt.pn * tstep : cB;
        for (int t = 0; t < nt; t += 2) {
            const bool last = (t == nt - 2);
            const char* a1 = cA + (size_t)(t + 1) * kstep;
            const char* a2 = last ? nA : cA + (size_t)(t + 2) * kstep; const char* b2 = last ? nB : cB + (size_t)(t + 2) * kstep;
            const char* a3 = a2 + kstep; const char* b3 = b2 + kstep;
            PG8_LDB(B0, 0, 0); PG8_SCHED; PG8_LDA(At, 0, 0); PG8_STAGE(PG8_SA(1, 1), a1 + hstep, voffA);
            PG8_WAIT_L(8); PG8_BAR; PG8_WAIT_L(0); PG8_MMA(0, 0, At, B0); PG8_BAR; PG8_SCHED;
            PG8_LDB(B1, 0, 1); PG8_STAGE(PG8_SB(0, 0), b2, voffB);
            PG8_BAR; PG8_WAIT_L(0); PG8_MMA(0, 1, At, B1); PG8_BAR;
            PG8_LDA(At, 0, 1); PG8_STAGE(PG8_SA(0, 0), a2, voffA);
            PG8_BAR; PG8_WAIT_L(0); PG8_MMA(1, 0, At, B0); PG8_BAR; PG8_SCHED;
            PG8_STAGE(PG8_SB(0, 1), b2 + hstep, voffB);
            PG8_WAIT_V(6); PG8_BAR; PG8_MMA(1, 1, At, B1); PG8_BAR;
            PG8_LDB(B0, 1, 0); PG8_SCHED; PG8_LDA(At, 1, 0); PG8_STAGE(PG8_SA(0, 1), a2 + hstep, voffA);
            PG8_WAIT_L(8); PG8_BAR; PG8_WAIT_L(0); PG8_MMA(0, 0, At, B0); PG8_BAR; PG8_SCHED;
            PG8_LDB(B1, 1, 1); PG8_STAGE(PG8_SB(1, 0), b3, voffB);
            PG8_BAR; PG8_WAIT_L(0); PG8_MMA(0, 1, At, B1); PG8_BAR;
            PG8_LDA(At, 1, 1); PG8_STAGE(PG8_SA(1, 0), a3, voffA);
            PG8_BAR; PG8_WAIT_L(0); PG8_MMA(1, 0, At, B0); PG8_BAR; PG8_SCHED;
            PG8_STAGE(PG8_SB(1, 1), b3 + hstep, voffB);
            PG8_WAIT_V(6); PG8_BAR; PG8_MMA(1, 1, At, B1); PG8_BAR;
        }
        E(acc, cur, wr, wc, fr, fq);
        if (!has_next) break;
#pragma unroll
        for (int a = 0; a < 2; ++a)
#pragma unroll
            for (int b = 0; b < 2; ++b)
#pragma unroll
                for (int m = 0; m < 4; ++m)
#pragma unroll
                    for (int n = 0; n < 2; ++n) acc[a][b][m][n] = (f32x4){0.f, 0.f, 0.f, 0.f};
        cur = nxt; cA = nA; cB = nB; ++ui;
    }
    PG8_WAIT_V(0);
    if (wr == 0) PG8_BAR;
    PG8_BAR;
#undef PG8_SA
#undef PG8_SB
#undef PG8_STAGE
#undef PG8_LDA
#undef PG8_LDB
#undef PG8_MMA
#undef PG8_WAIT_V
#undef PG8_WAIT_L
#undef PG8_BAR
#undef PG8_SCHED
}
}

template <class Epi>
__device__ __forceinline__ void run_gemm(unsigned char* lds, const bf16_t* A, const bf16_t* Bt, int M, int N, int K, const Epi& E, int Gv = -1, int cv = 0) {
    pg8::Gemm g{A, Bt, M, N, K}; pg8::StaticOrder S; if (Gv < 0) { Gv = (int)gridDim.x; cv = (int)blockIdx.x; } S.init(M, N, Gv, cv);
    pg8::gemm_phase<Epi>((LAS unsigned char*)lds, g, S, E);
    __syncthreads();
}

__device__ __forceinline__ void transpose_item(const float* W, int K, int N, bf16_t* WT, float* scr, int item, int nblk, int lane, const float* gk = nullptr) {
    const int kb = item / nblk, nb = item % nblk, k0 = 64 * kb, n0 = 32 * nb;
    const int n = n0 + (lane & 31);
#pragma unroll
    for (int i = 0; i < 32; ++i) { const int kk = 2 * i + (lane >> 5); scr[kk * 33 + (lane & 31)] = (n < N) ? __builtin_nontemporal_load(W + (size_t)(k0 + kk) * N + n) * (gk ? gk[k0 + kk] : 1.f) : 0.f; }
    __builtin_amdgcn_fence(__ATOMIC_RELEASE, "wavefront"); __builtin_amdgcn_wave_barrier(); __builtin_amdgcn_fence(__ATOMIC_ACQUIRE, "wavefront");
    const int c = lane & 7;
#pragma unroll
    for (int j = 0; j < 4; ++j) { const int nn = (lane >> 3) + 8 * j; const float* s = scr + (8 * c) * 33 + nn;
        u32x4 o; o.x = pk2(s[0 * 33], s[1 * 33]); o.y = pk2(s[2 * 33], s[3 * 33]); o.z = pk2(s[4 * 33], s[5 * 33]); o.w = pk2(s[6 * 33], s[7 * 33]);
        *(u32x4*)(WT + (size_t)(n0 + nn) * K + k0 + 8 * c) = o; }
    __builtin_amdgcn_fence(__ATOMIC_RELEASE, "wavefront"); __builtin_amdgcn_wave_barrier(); __builtin_amdgcn_fence(__ATOMIC_ACQUIRE, "wavefront");
}
__device__ __forceinline__ void rms_row_bf16(const float* x, const float* g, bf16_t* o, int lane) {
    f32x4 v[8]; float s = 0.f;
#pragma unroll
    for (int j = 0; j < 8; ++j) { v[j] = ((const f32x4*)x)[lane + 64 * j]; s += (v[j].x * v[j].x + v[j].y * v[j].y) + (v[j].z * v[j].z + v[j].w * v[j].w); }
    const float r = rsqrtf(wave_sum(s) * (1.f / 2048.f) + 1e-6f);
#pragma unroll
    for (int j = 0; j < 8; ++j) { const f32x4 gg = ((const f32x4*)g)[lane + 64 * j]; u32x2 w; w.x = pk2(v[j].x * r * gg.x, v[j].y * r * gg.y); w.y = pk2(v[j].z * r * gg.z, v[j].w * r * gg.w); ((u32x2*)o)[lane + 64 * j] = w; }
}
__device__ __forceinline__ void rms_row_f32(float* x, const float* g, int lane) {
    f32x4 v[8]; float s = 0.f;
#pragma unroll
    for (int j = 0; j < 8; ++j) { v[j] = ((const f32x4*)x)[lane + 64 * j]; s += (v[j].x * v[j].x + v[j].y * v[j].y) + (v[j].z * v[j].z + v[j].w * v[j].w); }
    const float r = rsqrtf(wave_sum(s) * (1.f / 2048.f) + 1e-6f);
#pragma unroll
    for (int j = 0; j < 8; ++j) { const f32x4 gg = ((const f32x4*)g)[lane + 64 * j]; ((f32x4*)x)[lane + 64 * j] = v[j] * r * gg; }
}
__device__ __forceinline__ void norm_rows_bf16(const float* X, const float* g, bf16_t* O, int rows) {
    const int lane = threadIdx.x & 63, gw = blockIdx.x * 8 + (threadIdx.x >> 6), NGW = gridDim.x * 8;
    int m = gw;
    for (; m + NGW < rows; m += 2 * NGW) {
        const float* xa = X + (size_t)m * DM; const float* xb = X + (size_t)(m + NGW) * DM;
        f32x4 va[8], vb[8]; float sa = 0.f, sb = 0.f;
#pragma unroll
        for (int j = 0; j < 8; ++j) { va[j] = __builtin_nontemporal_load((const f32x4*)xa + lane + 64 * j); vb[j] = __builtin_nontemporal_load((const f32x4*)xb + lane + 64 * j); }
#pragma unroll
        for (int j = 0; j < 8; ++j) { sa += (va[j].x * va[j].x + va[j].y * va[j].y) + (va[j].z * va[j].z + va[j].w * va[j].w); sb += (vb[j].x * vb[j].x + vb[j].y * vb[j].y) + (vb[j].z * vb[j].z + vb[j].w * vb[j].w); }
#pragma unroll
        for (int o = 1; o < 64; o <<= 1) { sa += __shfl_xor(sa, o); sb += __shfl_xor(sb, o); }
        const float ra = rsqrtf(sa * (1.f / 2048.f) + 1e-6f), rb = rsqrtf(sb * (1.f / 2048.f) + 1e-6f);
        u32x2* oa = (u32x2*)(O + (size_t)m * DM); u32x2* ob = (u32x2*)(O + (size_t)(m + NGW) * DM);
#pragma unroll
        for (int j = 0; j < 8; ++j) { const f32x4 gg = ((const f32x4*)g)[lane + 64 * j];
            u32x2 wa; wa.x = pk2(va[j].x * ra * gg.x, va[j].y * ra * gg.y); wa.y = pk2(va[j].z * ra * gg.z, va[j].w * ra * gg.w); oa[lane + 64 * j] = wa;
            u32x2 wb; wb.x = pk2(vb[j].x * rb * gg.x, vb[j].y * rb * gg.y); wb.y = pk2(vb[j].z * rb * gg.z, vb[j].w * rb * gg.w); ob[lane + 64 * j] = wb; }
    }
    for (; m < rows; m += NGW) rms_row_bf16(X + (size_t)m * DM, g, O + (size_t)m * DM, lane);
}

__device__ __forceinline__ void p0_prologue(const Args& a, unsigned char* lds) {
    const int tid = threadIdx.x, lane = tid & 63, wave = tid >> 6;
    float* scr = (float*)(lds + wave * 8448);
    const int gw = blockIdx.x * 8 + wave, NGW = gridDim.x * 8;
    unsigned char* ws = a.ws;
    constexpr int I_IN = 32 * 192, I_SQ = 32 * 64;
    constexpr int NITEMS = I_IN + 2 * I_SQ;
    for (int it = gw; it < NITEMS; it += NGW) {
        int r = it;
        if (r < I_IN) { transpose_item(a.in[3], DM, 6096, (bf16_t*)(ws + WS_WIN), scr, r, 192, lane); continue; } r -= I_IN;
        if (r < I_SQ) { transpose_item(a.in[25], DM, DM, (bf16_t*)(ws + WS_WK), scr, r, 64, lane); continue; } r -= I_SQ;
        transpose_item(a.in[26], DM, DM, (bf16_t*)(ws + WS_WV), scr, r, 64, lane);
    }
    {
        bf16_t* LT = (bf16_t*)(ws + WS_LORA); const float *w2 = a.in[12], *a2 = a.in[14], *g2 = a.in[15];
        for (int idx = blockIdx.x * 512 + tid; idx < 3072 * 512; idx += gridDim.x * 512) {
            const int n = idx >> 9, k = idx & 511, grp = n >> 10, nn = n & 1023; float v = 0.f;
            if (grp == 0) { if (k < 96) v = w2[k * 1024 + nn]; }
            else if (grp == 1) { if (k >= 96 && k < 192) v = a2[(k - 96) * 1024 + nn]; }
            else { if (k >= 192 && k < 448) v = g2[(k - 192) * 1024 + nn]; }
            LT[idx] = f2bf(v);
        }
    }
    { float* ssz = (float*)(ws + WS_SS); for (int i = blockIdx.x * 512 + tid; i < 3 * T_TOK; i += gridDim.x * 512) ssz[i] = 0.f; }
    norm_rows_bf16(a.in[0], a.in[2], (bf16_t*)(ws + WS_HN), T_TOK);
    norm_rows_bf16(a.in[1], a.in[23], (bf16_t*)(ws + WS_MN), 1024);
}

__device__ __forceinline__ void unpack8(const u32x4 u, float (&f)[8]) { f[0] = bflo(u.x); f[1] = bfhi(u.x); f[2] = bflo(u.y); f[3] = bfhi(u.y); f[4] = bflo(u.z); f[5] = bfhi(u.z); f[6] = bflo(u.w); f[7] = bfhi(u.w); }
__device__ __forceinline__ void lora_prep(const Args& a) {
    const bf16_t* U = (const bf16_t*)(a.ws + WS_U); bf16_t* LA = (bf16_t*)((unsigned char*)a.out + DO_LA); const float* mu = a.in[10];
#pragma unroll 2
    for (int idx = blockIdx.x * 512 + threadIdx.x; idx < T_TOK * 64; idx += gridDim.x * 512) {
        const int t = idx >> 6, c = (idx & 63) * 8; u32x4 w = (u32x4){0u, 0u, 0u, 0u};
        if (c < 448) {
            const bf16_t* up = U + (size_t)t * NU + 5648 + c;
            const u32x4 cu = *(const u32x4*)up; u32x4 pv = (u32x4){0u, 0u, 0u, 0u}; if (t & (SEQ - 1)) pv = *(const u32x4*)(up - NU);
            const f32x4 m0 = *(const f32x4*)(mu + 3072 + c), m1 = *(const f32x4*)(mu + 3072 + c + 4);
            float cur[8], prv[8], v[8]; unpack8(cu, cur); unpack8(pv, prv);
            const float mm[8] = {m0.x, m0.y, m0.z, m0.w, m1.x, m1.y, m1.z, m1.w};
#pragma unroll
            for (int j = 0; j < 8; ++j) { const float x = cur[j] + (prv[j] - cur[j]) * mm[j]; v[j] = c < 96 ? tanhf(x) : (c < 192 ? x : sigmoidf_(x)); }
            w.x = pk2(v[0], v[1]); w.y = pk2(v[2], v[3]); w.z = pk2(v[4], v[5]); w.w = pk2(v[6], v[7]);
        }
        *(u32x4*)(LA + (size_t)t * 512 + c) = w;
    }
}


__device__ __forceinline__ void ssd_passA(const Args& a, unsigned char* lds, int item) {
    const int tid = threadIdx.x, lane = tid & 63, wid = tid >> 6, fr = lane & 15, fq = lane >> 4;
    const int g = item & 1, c = (item >> 1) & 31, b = item >> 6;
    const int t0 = b * SEQ + c * 128;
    const bf16_t* U = (const bf16_t*)(a.ws + WS_U);
    unsigned char* dob = (unsigned char*)a.out;
    bf16_t* ST = (bf16_t*)(dob + DO_ST); bf16_t* XC = (bf16_t*)(dob + DO_XC); float* DT = (float*)(dob + DO_DT); float* CS = (float*)(dob + DO_CS);
    float* CD = (float*)(a.ws + WS_CD);
    float* dtl = (float*)lds; float* csl = dtl + 1024;
    bf16_t* BT = (bf16_t*)(lds + 8192); bf16_t* XT = BT + 128 * 136;
    const float* conv_w = a.in[4]; const float* conv_b = a.in[5];
    for (int idx = tid; idx < 1024; idx += 512) { const int e = idx >> 7, s = idx & 127, h = g * 8 + e;
        const float x = bf2f(U[(size_t)(t0 + s) * NU + 2560 + h]) + a.in[6][h]; const float dt = softplusf(x);
        dtl[idx] = dt; csl[idx] = dt * (-__expf(a.in[7][h])); }
    __syncthreads();
    { const int e = wid; const float v0 = csl[e * 128 + 2 * lane], v1 = csl[e * 128 + 2 * lane + 1]; float sum = v0 + v1;
#pragma unroll
      for (int off = 1; off < 64; off <<= 1) { const float n = __shfl_up(sum, off); if (lane >= off) sum += n; }
      const float excl = sum - (v0 + v1); csl[e * 128 + 2 * lane] = excl + v0; csl[e * 128 + 2 * lane + 1] = excl + v0 + v1; }
    __syncthreads();
    for (int idx = tid; idx < 1024; idx += 512) { const int e = idx >> 7, s = idx & 127, h = g * 8 + e; DT[(size_t)(t0 + s) * 16 + h] = dtl[idx]; CS[(size_t)(t0 + s) * 16 + h] = csl[idx]; }
    if (tid < 8) CD[(b * 32 + c) * 16 + g * 8 + tid] = __expf(csl[tid * 128 + 127]);
    for (int half = 0; half < 2; ++half) {
        const int ngroups = half ? 32 : 64, seglen = half ? 8 : 16;
        const int gi = tid % ngroups, seg = tid / ngroups;
        int col, kind;
        if (!half) { if (gi < 16) { col = 2048 + g * 128 + gi * 8; kind = 0; } else if (gi < 32) { col = 2304 + g * 128 + (gi - 16) * 8; kind = 1; } else { col = 1024 + g * 512 + (gi - 32) * 8; kind = 2; } }
        else { col = 1024 + g * 512 + 256 + gi * 8; kind = 2; }
        const int cc = col - 1024;
        float w0[8], w1[8], w2[8], w3[8], bb[8], x1[8], x2[8], x3[8], cur[8];
#pragma unroll
        for (int j = 0; j < 8; ++j) { w0[j] = conv_w[0 * 1536 + cc + j]; w1[j] = conv_w[1 * 1536 + cc + j]; w2[j] = conv_w[2 * 1536 + cc + j]; w3[j] = conv_w[3 * 1536 + cc + j]; bb[j] = conv_b[cc + j]; }
        const int s0 = seg * seglen;
        {
            const int sp = c * 128 + s0;
            const u32x4 z4 = (u32x4){0u, 0u, 0u, 0u};
            const u32x4 r1 = sp >= 3 ? *(const u32x4*)(U + (size_t)(t0 + s0 - 3) * NU + col) : z4;
            const u32x4 r2 = sp >= 2 ? *(const u32x4*)(U + (size_t)(t0 + s0 - 2) * NU + col) : z4;
            const u32x4 r3 = sp >= 1 ? *(const u32x4*)(U + (size_t)(t0 + s0 - 1) * NU + col) : z4;
            unpack8(r1, x1); unpack8(r2, x2); unpack8(r3, x3);
        }
        const int chg = cc - g * 512;
        const int e = (chg >> 6) & 7, eh = e & 3, p0 = chg & 63;
        for (int i = 0; i < seglen; ++i) {
            const int s = s0 + i;
            const u32x4 rc = *(const u32x4*)(U + (size_t)(t0 + s) * NU + col); unpack8(rc, cur);
            float v[8];
#pragma unroll
            for (int j = 0; j < 8; ++j) { const float o = bb[j] + w0[j] * x1[j] + w1[j] * x2[j] + w2[j] * x3[j] + w3[j] * cur[j]; v[j] = siluf_(o); x1[j] = x2[j]; x2[j] = x3[j]; x3[j] = cur[j]; }
            u32x4 w; w.x = pk2(v[0], v[1]); w.y = pk2(v[2], v[3]); w.z = pk2(v[4], v[5]); w.w = pk2(v[6], v[7]);
            *(u32x4*)(XC + (size_t)(t0 + s) * 1536 + cc) = w;
            if (kind == 0) {
#pragma unroll
                for (int j = 0; j < 8; ++j) BT[(gi * 8 + j) * 136 + s] = f2bf(v[j]);
            } else if (kind == 2) {
                const float sc = dtl[e * 128 + s] * __expf(csl[e * 128 + 127] - csl[e * 128 + s]);
#pragma unroll
                for (int j = 0; j < 8; ++j) XT[(eh * 64 + p0 + j) * 136 + s] = f2bf(v[j] * sc);
            }
        }
        __syncthreads();
        {
            const int eh2 = wid >> 1, nh = wid & 1, h = g * 8 + half * 4 + eh2;
            bf16_t* dst = ST + (size_t)((b * 32 + c) * 16 + h) * 8192;
#pragma unroll 1
            for (int rb = 0; rb < 4; ++rb) {
                f32x4 acc[4];
#pragma unroll
                for (int f = 0; f < 4; ++f) acc[f] = (f32x4){0.f, 0.f, 0.f, 0.f};
                wave_mma<4, 128, true>(acc, XT + (eh2 * 64 + rb * 16) * 136, 136, BT + (nh * 64) * 136, 136, fr, fq);
                const int p = rb * 16 + fr;
#pragma unroll
                for (int f = 0; f < 4; ++f) { u32x2 w; w.x = pk2(acc[f][0], acc[f][1]); w.y = pk2(acc[f][2], acc[f][3]); *(u32x2*)(dst + p * 128 + nh * 64 + 16 * f + 4 * fq) = w; }
            }
        }
        __syncthreads();
    }
}

__device__ __forceinline__ void ssd_state_scan(const Args& a) {
    bf16_t* ST = (bf16_t*)((unsigned char*)a.out + DO_ST); const float* CD = (const float*)(a.ws + WS_CD);
    for (int idx = blockIdx.x * 512 + threadIdx.x; idx < 4 * 16 * 2048; idx += gridDim.x * 512) {
        const int el = idx & 2047, h = (idx >> 11) & 15, b = idx >> 15;
        bf16_t* p0 = ST + (size_t)(b * 32 * 16 + h) * 8192 + el * 4;
        float h0 = 0.f, h1 = 0.f, h2 = 0.f, h3 = 0.f;
#pragma unroll 1
        for (int cb = 0; cb < 32; cb += 8) {
            u32x2 sv[8]; float dec[8];
#pragma unroll
            for (int c = 0; c < 8; ++c) { sv[c] = *(const u32x2*)(p0 + (size_t)(cb + c) * 16 * 8192); dec[c] = CD[(b * 32 + cb + c) * 16 + h]; }
#pragma unroll
            for (int c = 0; c < 8; ++c) {
                u32x2 w; w.x = pk2(h0, h1); w.y = pk2(h2, h3);
                *(u32x2*)(p0 + (size_t)(cb + c) * 16 * 8192) = w;
                h0 = h0 * dec[c] + bflo(sv[c].x); h1 = h1 * dec[c] + bfhi(sv[c].x); h2 = h2 * dec[c] + bflo(sv[c].y); h3 = h3 * dec[c] + bfhi(sv[c].y);
            }
        }
    }
}

__device__ __forceinline__ void ssd_passC(const Args& a, unsigned char* lds, int item) {
    const int tid = threadIdx.x, lane = tid & 63, wid = tid >> 6, fr = lane & 15, fq = lane >> 4;
    const int g = item & 1, c = (item >> 1) & 31, b = item >> 6;
    const int t0 = b * SEQ + c * 128;
    const bf16_t* U = (const bf16_t*)(a.ws + WS_U);
    unsigned char* dob = (unsigned char*)a.out;
    const bf16_t* ST = (const bf16_t*)(dob + DO_ST); const bf16_t* XC = (const bf16_t*)(dob + DO_XC); const float* DT = (const float*)(dob + DO_DT); const float* CS = (const float*)(dob + DO_CS);
    bf16_t* YM = (bf16_t*)(a.ws + WS_HN);
    float* dtl = (float*)lds; float* csl = dtl + 1024;
    bf16_t* Cn = (bf16_t*)(lds + 8192); bf16_t* Bn = Cn + 128 * 136; bf16_t* XdT = Bn + 128 * 136; bf16_t* StL = XdT + 64 * 136;
    bf16_t* Ml = Bn;
    for (int idx = tid; idx < 1024; idx += 512) { const int e = idx >> 7, s = idx & 127; dtl[idx] = DT[(size_t)(t0 + s) * 16 + g * 8 + e]; csl[idx] = CS[(size_t)(t0 + s) * 16 + g * 8 + e]; }
    for (int idx = tid; idx < 2048; idx += 512) { const int r = idx >> 4, ch = idx & 15;
        *(u32x4*)(Cn + r * 136 + ch * 8) = __builtin_nontemporal_load((const u32x4*)(XC + (size_t)(t0 + r) * 1536 + 1280 + g * 128 + ch * 8));
        *(u32x4*)(Bn + r * 136 + ch * 8) = __builtin_nontemporal_load((const u32x4*)(XC + (size_t)(t0 + r) * 1536 + 1024 + g * 128 + ch * 8)); }
    __syncthreads();
    f32x4 cb[8];
#pragma unroll
    for (int f = 0; f < 8; ++f) cb[f] = (f32x4){0.f, 0.f, 0.f, 0.f};
    wave_mma<8, 128, false>(cb, Cn + (16 * wid) * 136, 136, Bn, 136, fr, fq);
    __syncthreads();
    float ssum = 0.f;
    const int lrow = 16 * wid + fr;
#pragma unroll 1
    for (int e = 0; e < 8; ++e) {
        const int h = g * 8 + e;
#pragma unroll
        for (int f = 0; f < 8; ++f)
#pragma unroll
            for (int j = 0; j < 4; ++j) { const int l = 16 * wid + 4 * fq + j, s = 16 * f + fr;
                const float m = (s <= l) ? cb[f][j] * __expf(csl[e * 128 + l] - csl[e * 128 + s]) : 0.f;
                Ml[l * 136 + s] = f2bf(m); }
        { const int s = tid & 127, pg = tid >> 7; const bf16_t* src = XC + (size_t)(t0 + s) * 1536 + g * 512 + e * 64 + pg * 16;
          const u32x4 r0 = *(const u32x4*)src, r1 = *(const u32x4*)(src + 8); float x0[8], x1[8]; unpack8(r0, x0); unpack8(r1, x1);
          const float dts = dtl[e * 128 + s];
#pragma unroll
          for (int j = 0; j < 8; ++j) { XdT[(pg * 16 + j) * 136 + s] = f2bf(x0[j] * dts); XdT[(pg * 16 + 8 + j) * 136 + s] = f2bf(x1[j] * dts); } }
        { const bf16_t* src = ST + (size_t)((b * 32 + c) * 16 + h) * 8192;
          for (int idx = tid; idx < 1024; idx += 512) { const int r = idx >> 4, ch = idx & 15; *(u32x4*)(StL + r * 136 + ch * 8) = __builtin_nontemporal_load((const u32x4*)(src + r * 128 + ch * 8)); } }
        __syncthreads();
        f32x4 yd[4], yo[4];
#pragma unroll
        for (int f = 0; f < 4; ++f) { yd[f] = (f32x4){0.f, 0.f, 0.f, 0.f}; yo[f] = (f32x4){0.f, 0.f, 0.f, 0.f}; }
        wave_mma<4, 128, true>(yd, Ml + (16 * wid) * 136, 136, XdT, 136, fr, fq);
        wave_mma<4, 128, true>(yo, Cn + (16 * wid) * 136, 136, StL, 136, fr, fq);
        const float ecs = __expf(csl[e * 128 + lrow]), Dh = a.in[8][h];
#pragma unroll
        for (int f = 0; f < 4; ++f) { const int ch = g * 512 + e * 64 + 16 * f + 4 * fq;
            const u32x2 xr = *(const u32x2*)(XC + (size_t)(t0 + lrow) * 1536 + ch); const u32x2 zr = *(const u32x2*)(U + (size_t)(t0 + lrow) * NU + ch);
            const float xs[4] = {bflo(xr.x), bfhi(xr.x), bflo(xr.y), bfhi(xr.y)}; const float zz[4] = {bflo(zr.x), bfhi(zr.x), bflo(zr.y), bfhi(zr.y)};
            float y[4];
#pragma unroll
            for (int j = 0; j < 4; ++j) { y[j] = (yd[f][j] + ecs * yo[f][j] + xs[j] * Dh) * siluf_(zz[j]); ssum += y[j] * y[j]; }
            u32x2 w; w.x = pk2(y[0], y[1]); w.y = pk2(y[2], y[3]);
            *(u32x2*)(YM + (size_t)(t0 + lrow) * DM + ch) = w; }
        __syncthreads();
    }
    ssum += __shfl_xor(ssum, 16); ssum += __shfl_xor(ssum, 32);
    const float rstd = rsqrtf(ssum * (1.f / 512.f) + 1e-6f);
    const float* ng = a.in[9];
#pragma unroll 1
    for (int e = 0; e < 8; ++e)
#pragma unroll
        for (int f = 0; f < 4; ++f) { const int ch = g * 512 + e * 64 + 16 * f + 4 * fq; bf16_t* p = YM + (size_t)(t0 + lrow) * DM + ch;
            const u32x2 yr = *(const u32x2*)p; const f32x4 gg = *(const f32x4*)(ng + ch);
            u32x2 w; w.x = pk2(bflo(yr.x) * rstd * gg.x, bfhi(yr.x) * rstd * gg.y); w.y = pk2(bflo(yr.y) * rstd * gg.z, bfhi(yr.y) * rstd * gg.w);
            *(u32x2*)p = w; }
    __syncthreads();
}

constexpr int LATE_SQ = 32 * 64, LATE_1 = 32 * 256, LATE_2 = 128 * 64, LATE_ITEMS = 3 * LATE_SQ + LATE_1 + LATE_2;
struct LateTile { const float* W; bf16_t* WT; const float* gk; int K, N, k0, n0; };
__device__ __forceinline__ LateTile late_decode(const Args& a, int it) {
    unsigned char* ws = a.ws; LateTile d; d.gk = nullptr; int r = it, nblk;
    if (r < LATE_SQ) { d.W = a.in[21]; d.WT = (bf16_t*)(ws + WS_WOUT); d.K = DM; d.N = DM; nblk = 64; }
    else if ((r -= LATE_SQ) < LATE_SQ) { d.W = a.in[24]; d.WT = (bf16_t*)(ws + WS_WQ); d.K = DM; d.N = DM; nblk = 64; d.gk = a.in[22]; }
    else if ((r -= LATE_SQ) < LATE_SQ) { d.W = a.in[27]; d.WT = (bf16_t*)(ws + WS_WO); d.K = DM; d.N = DM; nblk = 64; }
    else if ((r -= LATE_SQ) < LATE_1) { d.W = a.in[29]; d.WT = (bf16_t*)(ws + WS_W1); d.K = DM; d.N = DFF; nblk = 256; d.gk = a.in[28]; }
    else { r -= LATE_1; d.W = a.in[30]; d.WT = (bf16_t*)(ws + WS_W2); d.K = DFF; d.N = DM; nblk = 64; }
    d.k0 = 64 * (r / nblk); d.n0 = 32 * (r % nblk); return d;
}
__device__ __forceinline__ void late_load(const LateTile& d, int sub, float (&v)[8], int lane) {
#pragma unroll
    for (int i = 0; i < 8; ++i) { const int kk = d.k0 + 16 * sub + 2 * i + (lane >> 5); v[i] = __builtin_nontemporal_load(d.W + (size_t)kk * d.N + d.n0 + (lane & 31)) * (d.gk ? d.gk[kk] : 1.f); }
}
__device__ __forceinline__ void late_stash(int sub, const float (&v)[8], float* scr, int lane) {
#pragma unroll
    for (int i = 0; i < 8; ++i) scr[(16 * sub + 2 * i + (lane >> 5)) * 33 + (lane & 31)] = v[i];
}
__device__ __forceinline__ void late_flush(const LateTile& d, float* scr, int lane) {
    __builtin_amdgcn_fence(__ATOMIC_RELEASE, "wavefront"); __builtin_amdgcn_wave_barrier(); __builtin_amdgcn_fence(__ATOMIC_ACQUIRE, "wavefront");
    const int c = lane & 7;
#pragma unroll
    for (int j = 0; j < 4; ++j) { const int nn = (lane >> 3) + 8 * j; const float* s = scr + (8 * c) * 33 + nn;
        u32x4 o; o.x = pk2(s[0 * 33], s[1 * 33]); o.y = pk2(s[2 * 33], s[3 * 33]); o.z = pk2(s[4 * 33], s[5 * 33]); o.w = pk2(s[6 * 33], s[7 * 33]);
        __builtin_nontemporal_store(o, (u32x4*)(d.WT + (size_t)(d.n0 + nn) * d.K + d.k0 + 8 * c)); }
    __builtin_amdgcn_fence(__ATOMIC_RELEASE, "wavefront"); __builtin_amdgcn_wave_barrier(); __builtin_amdgcn_fence(__ATOMIC_ACQUIRE, "wavefront");
}

struct RwRaw { u32x2 rc, rp, kc, kp, vc, vp, ee, aa; };
struct RwStep { f32x4 nkk, wr, w, kka, k2; float vi; f32x2 cc; };
__device__ __forceinline__ void rw_load(RwRaw& r, const bf16_t* U, const bf16_t* Eb, const bf16_t* Ab, int b, int sp, int chn) {
    const size_t t = (size_t)b * SEQ + sp; const bf16_t* ur = U + t * NU + 2576 + chn;
    r.rc = *(const u32x2*)ur; r.kc = *(const u32x2*)(ur + 1024); r.vc = *(const u32x2*)(ur + 2048);
    if (sp > 0) { r.rp = *(const u32x2*)(ur - NU); r.kp = *(const u32x2*)(ur - NU + 1024); r.vp = *(const u32x2*)(ur - NU + 2048); } else { r.rp = (u32x2){0u, 0u}; r.kp = r.rp; r.vp = r.rp; }
    r.ee = *(const u32x2*)(Eb + t * 1024 + chn); r.aa = *(const u32x2*)(Ab + t * 1024 + chn);
}
__device__ __forceinline__ void rwkv_scan(const Args& a, unsigned char* lds, int item, bool do_late) {
    const int tid = threadIdx.x, lane = tid & 63, wid = tid >> 6;
    const int quarter = item & 3, h = (item >> 2) & 15, b = item >> 6;
    const bf16_t* U = (const bf16_t*)(a.ws + WS_U); const bf16_t* Eb = (const bf16_t*)(a.ws + WS_E); const bf16_t* Ab = (const bf16_t*)(a.ws + WS_A);
    float* BN = (float*)(a.ws + WS_BN); bf16_t* YR = (bf16_t*)((unsigned char*)a.out + DO_YR);
    float* OP = (float*)lds;
    float* VV = OP + 2 * 10240;
    float* CC = VV + 2 * 2048;
    float* YB = CC + 2 * 64;
    if (wid >= 4) {
        const int ptid = tid - 256, cq = ptid & 15, tt0 = ptid >> 4, chn = h * 64 + 4 * cq;
        const float* mu = a.in[10];
        float mur[4], muk[4], muv[4], kkw[4], kaw[4], rkw[4];
#pragma unroll
        for (int j = 0; j < 4; ++j) { mur[j] = mu[chn + j]; muk[j] = mu[1024 + chn + j]; muv[j] = mu[2048 + chn + j]; kkw[j] = a.in[16][chn + j]; kaw[j] = a.in[17][chn + j]; rkw[j] = a.in[18][chn + j]; }
        float* lscr = (float*)(lds + 102912 + (wid - 4) * 8448);
        const int NPW = (int)gridDim.x * 4; int late_it = (int)blockIdx.x * 4 + (wid - 4); int late_sub = 0; LateTile ld_{}; float lv[8];
        RwRaw raw[2];
        rw_load(raw[0], U, Eb, Ab, b, tt0, chn); rw_load(raw[1], U, Eb, Ab, b, tt0 + 16, chn);
#pragma unroll 1
        for (int chunk = 0; chunk <= 128; ++chunk) {
            const bool late_on = do_late && chunk >= 2 && late_it < LATE_ITEMS;
            if (late_on) { if (late_sub == 0) ld_ = late_decode(a, late_it); late_load(ld_, late_sub, lv, lane); }
            if (chunk < 128) {
                float* OPb = OP + (chunk & 1) * 10240; float* VVb = VV + (chunk & 1) * 2048; float* CCb = CC + (chunk & 1) * 64;
#pragma unroll
                for (int k2i = 0; k2i < 2; ++k2i) {
                    const RwRaw rr = raw[k2i]; const int tt = tt0 + 16 * k2i;
                    const float rcf[4] = {bflo(rr.rc.x), bfhi(rr.rc.x), bflo(rr.rc.y), bfhi(rr.rc.y)}, rpf[4] = {bflo(rr.rp.x), bfhi(rr.rp.x), bflo(rr.rp.y), bfhi(rr.rp.y)};
                    const float kcf[4] = {bflo(rr.kc.x), bfhi(rr.kc.x), bflo(rr.kc.y), bfhi(rr.kc.y)}, kpf[4] = {bflo(rr.kp.x), bfhi(rr.kp.x), bflo(rr.kp.y), bfhi(rr.kp.y)};
                    const float vcf[4] = {bflo(rr.vc.x), bfhi(rr.vc.x), bflo(rr.vc.y), bfhi(rr.vc.y)}, vpf[4] = {bflo(rr.vp.x), bfhi(rr.vp.x), bflo(rr.vp.y), bfhi(rr.vp.y)};
                    const float ef[4] = {bflo(rr.ee.x), bfhi(rr.ee.x), bflo(rr.ee.y), bfhi(rr.ee.y)}, af[4] = {bflo(rr.aa.x), bfhi(rr.aa.x), bflo(rr.aa.y), bfhi(rr.aa.y)};
                    if (chunk + 1 < 128) rw_load(raw[k2i], U, Eb, Ab, b, (chunk + 1) * 32 + tt, chn);
                    float r[4], k[4], v[4], w[4], kk[4], k2[4], kka[4], wr[4]; float ss = 0.f, c1 = 0.f, c2 = 0.f, bn = 0.f;
#pragma unroll
                    for (int j = 0; j < 4; ++j) { r[j] = rcf[j] + (rpf[j] - rcf[j]) * mur[j]; k[j] = kcf[j] + (kpf[j] - kcf[j]) * muk[j]; v[j] = vcf[j] + (vpf[j] - vcf[j]) * muv[j];
                        w[j] = __expf(-ef[j]); kk[j] = k[j] * kkw[j]; ss += kk[j] * kk[j]; }
                    ss = row16_sum(ss);
                    const float inv = 1.f / fmaxf(sqrtf(ss), 1e-12f);
#pragma unroll
                    for (int j = 0; j < 4; ++j) { kk[j] *= inv; k2[j] = k[j] * (1.f + (af[j] - 1.f) * kaw[j]); kka[j] = kk[j] * af[j]; wr[j] = w[j] * r[j];
                        c1 += kka[j] * r[j]; c2 += k2[j] * r[j]; bn += r[j] * k2[j] * rkw[j]; }
                    c1 = row16_sum(c1); c2 = row16_sum(c2); bn = row16_sum(bn);
                    float* op = OPb + tt * 320 + cq * 20;
                    *(f32x4*)(op) = (f32x4){-kk[0], -kk[1], -kk[2], -kk[3]};
                    *(f32x4*)(op + 4) = (f32x4){wr[0], wr[1], wr[2], wr[3]};
                    *(f32x4*)(op + 8) = (f32x4){w[0], w[1], w[2], w[3]};
                    *(f32x4*)(op + 12) = (f32x4){kka[0], kka[1], kka[2], kka[3]};
                    *(f32x4*)(op + 16) = (f32x4){k2[0], k2[1], k2[2], k2[3]};
                    *(f32x4*)(VVb + tt * 64 + 4 * cq) = (f32x4){v[0], v[1], v[2], v[3]};
                    if (cq == 0) { CCb[2 * tt] = c1; CCb[2 * tt + 1] = c2; if (quarter == 0) BN[((size_t)b * SEQ + chunk * 32 + tt) * 16 + h] = bn; }
                }
            }
            if (late_on) { late_stash(late_sub, lv, lscr, lane); if (++late_sub == 4) { late_flush(ld_, lscr, lane); late_sub = 0; late_it += NPW; } }
            if (chunk >= 2) {
                const int yc = chunk - 2; const float* YBb = YB + (yc & 1) * 512;
                const int t2 = ptid >> 3, pr = ptid & 7; const f32x2 yy = *(const f32x2*)(YBb + t2 * 16 + 2 * pr);
                *(unsigned*)(YR + ((size_t)b * SEQ + yc * 32 + t2) * 1024 + h * 64 + quarter * 16 + 2 * pr) = pk2(yy.x, yy.y);
            }
            __syncthreads();
        }
        if (do_late) while (late_it < LATE_ITEMS) { if (late_sub == 0) ld_ = late_decode(a, late_it); late_load(ld_, late_sub, lv, lane); late_stash(late_sub, lv, lscr, lane); if (++late_sub == 4) { late_flush(ld_, lscr, lane); late_sub = 0; late_it += NPW; } }
        {   const int yc = 127; const float* YBb = YB + (yc & 1) * 512;
            const int t2 = ptid >> 3, pr = ptid & 7; const f32x2 yy = *(const f32x2*)(YBb + t2 * 16 + 2 * pr);
            *(unsigned*)(YR + ((size_t)b * SEQ + yc * 32 + t2) * 1024 + h * 64 + quarter * 16 + 2 * pr) = pk2(yy.x, yy.y); }
    } else {
        const int q = lane & 15, rloc = wid * 4 + (lane >> 4), irow = quarter * 16 + rloc;
        f32x2 S0 = (f32x2){0.f, 0.f}, S1 = (f32x2){0.f, 0.f};
        __syncthreads();
#pragma unroll 1
        for (int chunk = 0; chunk < 128; ++chunk) {
            const float* OPb = OP + (chunk & 1) * 10240; const float* VVb = VV + (chunk & 1) * 2048; const float* CCb = CC + (chunk & 1) * 64; float* YBb = YB + (chunk & 1) * 512;
#define RW_LD(o, s_) do { const float* op_ = OPb + (s_) * 320 + q * 20; o.nkk = *(const f32x4*)(op_); o.wr = *(const f32x4*)(op_ + 4); o.w = *(const f32x4*)(op_ + 8); o.kka = *(const f32x4*)(op_ + 12); o.k2 = *(const f32x4*)(op_ + 16); \
                o.vi = VVb[(s_) * 64 + irow]; o.cc = *(const f32x2*)(CCb + 2 * (s_)); } while (0)
#define RW_STEP(o, s_) do { const f32x2 p_ = S0 * o.nkk.lo + S1 * o.nkk.hi; const f32x2 r_ = S0 * o.wr.lo + S1 * o.wr.hi; \
                const f32x2 t0_ = S0 * o.w.lo + o.vi * o.k2.lo; const f32x2 t1_ = S1 * o.w.hi + o.vi * o.k2.hi; \
                float d1 = p_.x + p_.y, d2 = r_.x + r_.y; row16_sum2(d1, d2); \
                S0 = t0_ + d1 * o.kka.lo; S1 = t1_ + d1 * o.kka.hi; YBb[(s_) * 16 + rloc] = d2 + d1 * o.cc.x + o.vi * o.cc.y; } while (0)
            RwStep o0, o1, n0, n1;
            RW_LD(o0, 0); RW_LD(o1, 1);
#pragma unroll
            for (int s = 0; s < 32; s += 2) {
                if (s + 2 < 32) { RW_LD(n0, s + 2); RW_LD(n1, s + 3); }
                __builtin_amdgcn_sched_barrier(0);
                RW_STEP(o0, s); RW_STEP(o1, s + 1);
                __builtin_amdgcn_sched_barrier(0);
                o0 = n0; o1 = n1;
            }
#undef RW_LD
#undef RW_STEP
            __syncthreads();
        }
    }
    __syncthreads();
}

__device__ __forceinline__ void rwkv_post(const Args& a) {
    const int lane = threadIdx.x & 63, gw = blockIdx.x * 8 + (threadIdx.x >> 6), NGW = gridDim.x * 8;
    const bf16_t* U = (const bf16_t*)(a.ws + WS_U); const bf16_t* Gb = (const bf16_t*)(a.ws + WS_G); const float* BN = (const float*)(a.ws + WS_BN);
    const bf16_t* YR = (const bf16_t*)((unsigned char*)a.out + DO_YR); bf16_t* YM = (bf16_t*)(a.ws + WS_HN);
    const float* mu = a.in[10]; const float* lnw = a.in[19]; const float* lnb = a.in[20];
    const int cq = lane & 15;
#pragma unroll 2
    for (int pb = gw * 4; pb < T_TOK * 16; pb += NGW * 4) {
        const int pair = pb + (lane >> 4), t = pair >> 4, h = pair & 15, ch = h * 64 + 4 * cq;
        const u32x2 yr = __builtin_nontemporal_load((const u32x2*)(YR + (size_t)t * 1024 + ch));
        const float y[4] = {bflo(yr.x), bfhi(yr.x), bflo(yr.y), bfhi(yr.y)};
        const float mean = row16_sum((y[0] + y[1]) + (y[2] + y[3])) * (1.f / 64.f);
        float vs = 0.f;
#pragma unroll
        for (int j = 0; j < 4; ++j) vs += (y[j] - mean) * (y[j] - mean);
        const float rstd = rsqrtf(row16_sum(vs) * (1.f / 64.f) + 64e-5f);
        const bf16_t* uv = U + (size_t)t * NU + 4624 + ch;
        const u32x2 vcr = __builtin_nontemporal_load((const u32x2*)uv); u32x2 vpr = (u32x2){0u, 0u}; if (t & (SEQ - 1)) vpr = *(const u32x2*)(uv - NU);
        const float vc[4] = {bflo(vcr.x), bfhi(vcr.x), bflo(vcr.y), bfhi(vcr.y)}, vp[4] = {bflo(vpr.x), bfhi(vpr.x), bflo(vpr.y), bfhi(vpr.y)};
        const u32x2 gr = __builtin_nontemporal_load((const u32x2*)(Gb + (size_t)t * 1024 + ch)); const float gt[4] = {bflo(gr.x), bfhi(gr.x), bflo(gr.y), bfhi(gr.y)};
        const float bn = BN[(size_t)t * 16 + h];
        float o[4];
#pragma unroll
        for (int j = 0; j < 4; ++j) { const float v = vc[j] + (vp[j] - vc[j]) * mu[2048 + ch + j]; o[j] = ((y[j] - mean) * rstd * lnw[ch + j] + lnb[ch + j] + bn * v) * gt[j]; }
        u32x2 w; w.x = pk2(o[0], o[1]); w.y = pk2(o[2], o[3]);
        *(u32x2*)(YM + (size_t)t * DM + 1024 + ch) = w;
    }
}

__device__ __forceinline__ void attn_item(const Args& a, unsigned char* lds, int item) {
    const int tid = threadIdx.x, lane = tid & 63, wid = tid >> 6, fr = lane & 15, fq = lane >> 4;
    const int qt = item & 31, hd = (item >> 5) & 3, b = item >> 7;
    const int t0 = b * SEQ + qt * 128;
    const bf16_t* Q = (const bf16_t*)(a.ws + WS_U); bf16_t* Ob = (bf16_t*)(a.ws + WS_HN); const bf16_t* Kx = (const bf16_t*)(a.ws + WS_KX); const bf16_t* Vt = (const bf16_t*)(a.ws + WS_VT);
    bf16_t* Qs = (bf16_t*)lds; bf16_t* Ks = Qs + 128 * 72; bf16_t* Vs = (bf16_t*)lds; bf16_t* Ps = (bf16_t*)(lds + 55296);
    f32x4 s[16];
#pragma unroll
    for (int f = 0; f < 16; ++f) s[f] = (f32x4){0.f, 0.f, 0.f, 0.f};
    u32x4 qr[2], kr[4];
#define AT_LOADQK(dc_) do { _Pragma("unroll") for (int i_ = 0; i_ < 2; ++i_) { const int idx = tid + 512 * i_, r = idx >> 3, ch = idx & 7; qr[i_] = __builtin_nontemporal_load((const u32x4*)(Q + (size_t)(t0 + r) * DM + hd * 512 + (dc_) * 64 + ch * 8)); } \
        _Pragma("unroll") for (int i_ = 0; i_ < 4; ++i_) { const int idx = tid + 512 * i_, r = idx >> 3, ch = idx & 7; kr[i_] = *(const u32x4*)(Kx + (size_t)(b * 256 + r) * DM + hd * 512 + (dc_) * 64 + ch * 8); } } while (0)
    AT_LOADQK(0);
#pragma unroll 1
    for (int dc = 0; dc < 8; ++dc) {
#pragma unroll
        for (int i_ = 0; i_ < 2; ++i_) { const int idx = tid + 512 * i_, r = idx >> 3, ch = idx & 7; *(u32x4*)(Qs + r * 72 + ch * 8) = qr[i_]; }
#pragma unroll
        for (int i_ = 0; i_ < 4; ++i_) { const int idx = tid + 512 * i_, r = idx >> 3, ch = idx & 7; *(u32x4*)(Ks + r * 72 + ch * 8) = kr[i_]; }
        __syncthreads();
        if (dc + 1 < 8) AT_LOADQK(dc + 1);
        wave_mma<16, 64, false>(s, Qs + (16 * wid) * 72, 72, Ks, 72, fr, fq);
        __syncthreads();
    }
#undef AT_LOADQK
    u32x4 vr[4];
#define AT_LOADV(dc_) do { _Pragma("unroll") for (int i_ = 0; i_ < 4; ++i_) { const int idx = tid + 512 * i_, r = idx >> 5, ch = idx & 31; vr[i_] = *(const u32x4*)(Vt + (size_t)(hd * 512 + (dc_) * 64 + r) * 1024 + b * 256 + ch * 8); } } while (0)
    AT_LOADV(0);
    const float scale = 0.04419417382415922f;
#pragma unroll
    for (int j = 0; j < 4; ++j) {
        float mx = s[0][j];
#pragma unroll
        for (int f = 1; f < 16; ++f) mx = fmaxf(mx, s[f][j]);
        mx = row16_max(mx);
        float sum = 0.f;
#pragma unroll
        for (int f = 0; f < 16; ++f) { const float p = __expf((s[f][j] - mx) * scale); s[f][j] = p; sum += p; }
        sum = row16_sum(sum);
        const float inv = 1.f / sum;
#pragma unroll
        for (int f = 0; f < 16; ++f) Ps[(16 * wid + 4 * fq + j) * 264 + 16 * f + fr] = f2bf(s[f][j] * inv);
    }
#pragma unroll 1
    for (int dc = 0; dc < 8; ++dc) {
        __syncthreads();
#pragma unroll
        for (int i_ = 0; i_ < 4; ++i_) { const int idx = tid + 512 * i_, r = idx >> 5, ch = idx & 31; *(u32x4*)(Vs + r * 264 + ch * 8) = vr[i_]; }
        __syncthreads();
        if (dc + 1 < 8) AT_LOADV(dc + 1);
        f32x4 o[4];
#pragma unroll
        for (int f = 0; f < 4; ++f) o[f] = (f32x4){0.f, 0.f, 0.f, 0.f};
        wave_mma<4, 256, true>(o, Ps + (16 * wid) * 264, 264, Vs, 264, fr, fq);
#pragma unroll
        for (int f = 0; f < 4; ++f) { u32x2 w; w.x = pk2(o[f][0], o[f][1]); w.y = pk2(o[f][2], o[f][3]);
            *(u32x2*)(Ob + (size_t)(t0 + 16 * wid + fr) * DM + hd * 512 + dc * 64 + 16 * f + 4 * fq) = w; }
    }
#undef AT_LOADV
    __syncthreads();
}


#define XB_TMO      128
#define XB_XCNT(j)  (256  + 64 * (j))
#define XB_XSUB(j)  (1280 + 64 * (j))
#define XB_XGEN(j)  (2304 + 64 * (j))
#define XB_TOP      3328
#define XB_TOPGEN   3392
#define XCD_BAR_WORDS 3456
#define XB_SPIN_CAP (1u << 18)
__device__ __forceinline__ unsigned xb_ld(unsigned* p)              { return __hip_atomic_load(p, __ATOMIC_RELAXED, __HIP_MEMORY_SCOPE_AGENT); }
__device__ __forceinline__ unsigned xb_add(unsigned* p, unsigned v) { return __hip_atomic_fetch_add(p, v, __ATOMIC_RELAXED, __HIP_MEMORY_SCOPE_AGENT); }
__device__ __forceinline__ unsigned xb_xcc_id() { return (unsigned)__builtin_amdgcn_s_getreg((3 << 11) | 20) & 0xFu; }
#define XB_SPIN(cond, bar) do { unsigned _sp = 0; while (cond) { __builtin_amdgcn_s_sleep(1); \
    if ((++_sp & 255u) == 0u) { if (xb_ld(&(bar)[XB_TMO])) break; if (_sp > XB_SPIN_CAP) { atomicAdd(&(bar)[XB_TMO], 1u); break; } } } } while (0)
struct XcdBarrier { unsigned* bar; unsigned x; volatile LAS unsigned* st; };
__device__ __forceinline__ XcdBarrier xcd_barrier_post(unsigned* bar, volatile LAS unsigned* st) {
    XcdBarrier b; b.bar = bar; b.x = xb_xcc_id(); b.st = st;
    if (threadIdx.x == 0) (void)xb_add(&bar[XB_XCNT(b.x)], 1u);
    return b;
}
__device__ __forceinline__ void xcd_barrier_complete(unsigned* bar, unsigned x, unsigned& nloc, unsigned& nx) {
    const unsigned G = gridDim.x * gridDim.y * gridDim.z;
    unsigned sum, cnt, mine, sp = 0u;
    for (;;) {
        sum = 0u; cnt = 0u; mine = 0u;
#pragma unroll
        for (unsigned j = 0; j < 16; ++j) { const unsigned c = xb_ld(&bar[XB_XCNT(j)]); sum += c; cnt += (c > 0u) ? 1u : 0u; mine = (j == x) ? c : mine; }
        if (sum == G) break;
        __builtin_amdgcn_s_sleep(1);
        if ((++sp & 255u) == 0u) { if (xb_ld(&bar[XB_TMO])) break; if (sp > XB_SPIN_CAP) { atomicAdd(&bar[XB_TMO], 1u); break; } }
    }
    nloc = mine > 0u ? mine : 1u; nx = cnt > 0u ? cnt : 1u;
}
__device__ __forceinline__ void xcd_barrier(const XcdBarrier& b) {
    asm volatile("s_waitcnt vmcnt(0)" ::: "memory");
    __syncthreads();
    if (threadIdx.x == 0) {
        unsigned* bar = b.bar;
        __builtin_amdgcn_s_waitcnt(0);
        unsigned nloc = b.st[0], nx = b.st[1];
        if (nloc == 0u) { xcd_barrier_complete(bar, b.x, nloc, nx); b.st[0] = nloc; b.st[1] = nx; }
        const unsigned old = xb_add(&bar[XB_XSUB(b.x)], 1u);
        const unsigned gen = old / nloc;
        if (old + 1u == (gen + 1u) * nloc) {
            __builtin_amdgcn_fence(__ATOMIC_RELEASE, "agent");
            asm volatile("s_waitcnt vmcnt(0)" ::: "memory");
            const unsigned og = xb_add(&bar[XB_TOP], 1u);
            const unsigned tg = og / nx;
            if (og + 1u == (tg + 1u) * nx) xb_add(&bar[XB_TOPGEN], 1u);
            else XB_SPIN(xb_ld(&bar[XB_TOPGEN]) == tg, bar);
            __builtin_amdgcn_fence(__ATOMIC_ACQUIRE, "agent");
            xb_add(&bar[XB_XGEN(b.x)], 1u);
            asm volatile("s_waitcnt vmcnt(0)" ::: "memory");
        } else {
            XB_SPIN(xb_ld(&bar[XB_XGEN(b.x)]) == gen, bar);
            __builtin_amdgcn_fence(__ATOMIC_ACQUIRE, "agent");
            asm volatile("s_waitcnt vmcnt(0)" ::: "memory");
        }
    }
    __syncthreads();
}

constexpr int NPHASE = 14;
#ifndef REP_PH
#define REP_PH -1
#endif
#define NREP(k) ((k) == REP_PH ? 2 : 1)
__global__ void __launch_bounds__(512, 2) hymba_fwd(Args a) {
    extern __shared__ __attribute__((aligned(16))) unsigned char lds[];
    cg::grid_group grid = cg::this_grid();
    unsigned char* ws = a.ws;
    const int G = gridDim.x, bid = blockIdx.x;
    volatile LAS unsigned* xst = (volatile LAS unsigned*)((LAS unsigned char*)lds + 139264);
    if (threadIdx.x < 2) xst[threadIdx.x] = 0u;
    __syncthreads();
    const int vb = (G % 8 == 0) ? (bid % 8) * (G / 8) + bid / 8 : bid;
    const XcdBarrier xbar = xcd_barrier_post((unsigned*)(a.ws + WS_BAR), xst);
    if (a.ph_hi < 0) grid.sync();
#define IN(k) (a.ph_lo <= (k) && (k) < a.ph_hi)
#define SEAM(k) do { if (a.ph_lo <= (k) && (k) + 1 < a.ph_hi) xcd_barrier(xbar); } while (0)
    bf16_t* HN = (bf16_t*)(ws + WS_HN); bf16_t* Ub = (bf16_t*)(ws + WS_U);
    if (IN(0)) for (int rp_ = 0; rp_ < NREP(0); ++rp_) p0_prologue(a, lds);
    SEAM(0);
    if (IN(1)) for (int rp_ = 0; rp_ < NREP(1); ++rp_) run_gemm(lds, HN, (const bf16_t*)(ws + WS_WIN), T_TOK, NU, DM, pg8::EpiBf16{Ub, NU, 0, nullptr});
    SEAM(1);
    if (IN(2)) for (int rp_ = 0; rp_ < NREP(2); ++rp_) { lora_prep(a); for (int it = vb; it < 256; it += G) ssd_passA(a, lds, it); }
    SEAM(2);
    if (IN(3)) {
        const pg8::EpiLora EL{(bf16_t*)(ws + WS_E), (bf16_t*)(ws + WS_A), (bf16_t*)(ws + WS_G), a.in[11], a.in[13]};
        const bf16_t* LAp = (const bf16_t*)((unsigned char*)a.out + DO_LA);
        if (G == 256) {
            if (bid < 32) run_gemm(lds, (const bf16_t*)(ws + WS_MN), (const bf16_t*)(ws + WS_WK), 1024, DM, DM, pg8::EpiBf16{(bf16_t*)(ws + WS_KX), DM, 0, nullptr}, 32, bid);
            else if (bid < 64) run_gemm(lds, (const bf16_t*)(ws + WS_WV), (const bf16_t*)(ws + WS_MN), DM, 1024, DM, pg8::EpiBf16{(bf16_t*)(ws + WS_VT), 1024, 0, nullptr}, 32, bid - 32);
            else run_gemm(lds, LAp, (const bf16_t*)(ws + WS_LORA), T_TOK, 3072, 512, EL, 192, bid - 64);
        } else {
            run_gemm(lds, (const bf16_t*)(ws + WS_MN), (const bf16_t*)(ws + WS_WK), 1024, DM, DM, pg8::EpiBf16{(bf16_t*)(ws + WS_KX), DM, 0, nullptr});
            run_gemm(lds, (const bf16_t*)(ws + WS_WV), (const bf16_t*)(ws + WS_MN), DM, 1024, DM, pg8::EpiBf16{(bf16_t*)(ws + WS_VT), 1024, 0, nullptr});
            run_gemm(lds, LAp, (const bf16_t*)(ws + WS_LORA), T_TOK, 3072, 512, EL);
        }
        ssd_state_scan(a);
    }
    SEAM(3);
    if (IN(4)) for (int rp_ = 0; rp_ < NREP(4); ++rp_) {
        for (int r2 = 0; r2 < NREP(41); ++r2) for (int it = vb; it < 256; it += G) ssd_passC(a, lds, it);
        for (int r2 = 0; r2 < NREP(42); ++r2) for (int it = vb; it < 256; it += G) rwkv_scan(a, lds, it, it == vb);
    }
    SEAM(4);
    if (IN(5)) for (int rp_ = 0; rp_ < NREP(5); ++rp_) rwkv_post(a);
    SEAM(5);
    bf16_t* Xb = (bf16_t*)(ws + WS_E);
    bf16_t* Fb = (bf16_t*)(ws + WS_HN);
    float* SS1 = (float*)(ws + WS_SS); float* SS2 = SS1 + T_TOK; float* SS3 = SS2 + T_TOK;
    if (IN(6)) for (int rp_ = 0; rp_ < NREP(6); ++rp_) run_gemm(lds, HN, (const bf16_t*)(ws + WS_WOUT), T_TOK, DM, DM, pg8::EpiResBf16<false>{a.in[0], Xb, DM, SS1});
    SEAM(6);
    if (IN(8)) for (int rp_ = 0; rp_ < NREP(8); ++rp_) run_gemm(lds, Xb, (const bf16_t*)(ws + WS_WQ), T_TOK, DM, DM, pg8::EpiBf16{Ub, DM, 0, SS1});
    SEAM(8);
    if (IN(9)) for (int rp_ = 0; rp_ < NREP(9); ++rp_) for (int it = vb; it < 512; it += G) attn_item(a, lds, it);
    SEAM(9);
    if (IN(10)) run_gemm(lds, HN, (const bf16_t*)(ws + WS_WO), T_TOK, DM, DM, pg8::EpiResBf16<true>{Xb, Xb, DM, SS2});
    SEAM(10);
    if (IN(12)) for (int rp_ = 0; rp_ < NREP(12); ++rp_) run_gemm(lds, Xb, (const bf16_t*)(ws + WS_W1), T_TOK, DFF, DM, pg8::EpiBf16{Fb, DFF, 1, SS2});
    SEAM(12);
    if (IN(13)) run_gemm(lds, Fb, (const bf16_t*)(ws + WS_W2), T_TOK, DM, DFF, pg8::EpiResBf16<true>{Xb, Xb, DM, SS3});
    SEAM(13);
    if (IN(14)) { const f32x4* g4 = (const f32x4*)a.in[31];
#pragma unroll 4
        for (int idx = bid * 512 + threadIdx.x; idx < T_TOK * 256; idx += G * 512) {
            const int row = idx >> 8, c8 = idx & 255; const float rs = rsqrtf(SS3[row] * (1.f / 2048.f) + 1e-6f);
            const u32x4 r = __builtin_nontemporal_load((const u32x4*)(Xb + (size_t)row * DM + c8 * 8)); const f32x4 ga = g4[c8 * 2], gb = g4[c8 * 2 + 1];
            f32x4 o0 = (f32x4){bflo(r.x), bfhi(r.x), bflo(r.y), bfhi(r.y)}, o1 = (f32x4){bflo(r.z), bfhi(r.z), bflo(r.w), bfhi(r.w)};
            o0 = o0 * rs * ga; o1 = o1 * rs * gb;
            f32x4* op = (f32x4*)(a.out + (size_t)row * DM + c8 * 8); __builtin_nontemporal_store(o0, op); __builtin_nontemporal_store(o1, op + 1); } }
#undef IN
#undef SEAM
}

extern "C" void kernel_launch(void* const* d_in, const int* in_sizes, int n_in, void* d_out, int out_size, void* d_ws, size_t ws_size, hipStream_t stream) {
    static int grid = 0;
    if (grid == 0) {
        if (n_in != 32 || out_size != T_TOK * DM || ws_size < WS_END) { fprintf(stderr, "kernel_launch: unexpected shapes (n_in %d out %d ws %zu)\n", n_in, out_size, ws_size); grid = -1; return; }
        int dev = 0, cus = 0, per_cu = 0;
        (void)hipGetDevice(&dev); (void)hipDeviceGetAttribute(&cus, hipDeviceAttributeMultiprocessorCount, dev);
        if (hipFuncSetAttribute((const void*)hymba_fwd, hipFuncAttributeMaxDynamicSharedMemorySize, LDS_BYTES) != hipSuccess) { fprintf(stderr, "kernel_launch: hipFuncSetAttribute failed\n"); grid = -1; return; }
        if (hipOccupancyMaxActiveBlocksPerMultiprocessor(&per_cu, (const void*)hymba_fwd, 512, LDS_BYTES) != hipSuccess || per_cu < 1) per_cu = 1;
        (void)hipGetLastError();
        grid = cus * 1;
        if (grid <= 0) grid = 256;
    }
    if (grid < 0) return;
    (void)hipMemsetAsync((char*)d_ws + WS_BAR, 0, XCD_BAR_WORDS * 4, stream);
    Args a{};
    for (int i = 0; i < 32; ++i) a.in[i] = (const float*)d_in[i];
    a.out = (float*)d_out; a.ws = (unsigned char*)d_ws; a.ph_lo = 0; a.ph_hi = NPHASE + 1;
    void* args[] = {&a};
    hipError_t e = hipLaunchCooperativeKernel((const void*)hymba_fwd, dim3(grid), dim3(512), args, LDS_BYTES, stream);
    if (e != hipSuccess) fprintf(stderr, "kernel_launch: cooperative launch failed: %s (grid %d)\n", hipGetErrorString(e), grid);
}
```

```cpp
#include <hip/hip_runtime.h>
#include <hip/hip_cooperative_groups.h>
#include <cstdio>
namespace cg = cooperative_groups;

typedef unsigned short bf16_t;
typedef short bf16x8 __attribute__((ext_vector_type(8)));
typedef float f32x4 __attribute__((ext_vector_type(4)));
typedef float f32x2 __attribute__((ext_vector_type(2)));
typedef unsigned u32x4 __attribute__((ext_vector_type(4)));
typedef unsigned u32x2 __attribute__((ext_vector_type(2)));
#define LAS __attribute__((address_space(3)))

constexpr int T_TOK = 16384, SEQ = 4096, DM = 2048, NU = 6144, DFF = 8192;
constexpr int LDS_BYTES = 140 * 1024;
constexpr size_t MiB = 1u << 20;
constexpr size_t WS_WIN = 0, WS_WOUT = 24 * MiB, WS_WQ = 32 * MiB, WS_WK = 40 * MiB, WS_WV = 48 * MiB, WS_WO = 56 * MiB, WS_W1 = 64 * MiB, WS_W2 = 96 * MiB,
                 WS_LORA = 128 * MiB, WS_MN = 132 * MiB, WS_KX = 136 * MiB, WS_VT = 140 * MiB, WS_HN = 144 * MiB, WS_U = 208 * MiB,
                 WS_E = 400 * MiB, WS_A = 432 * MiB, WS_G = 464 * MiB, WS_BN = 496 * MiB, WS_CD = 497 * MiB, WS_BAR = 498 * MiB, WS_SS = 499 * MiB, WS_END = 500 * MiB;
constexpr size_t DO_ST = 0, DO_XC = 32 * MiB, DO_DT = 80 * MiB, DO_CS = 81 * MiB, DO_LA = 82 * MiB, DO_YR = 82 * MiB;

struct Args { const float* in[32]; float* out; unsigned char* ws; int ph_lo, ph_hi; };

__device__ __forceinline__ float bf2f(unsigned v) { return __uint_as_float(v << 16); }
__device__ __forceinline__ float bflo(unsigned v) { return __uint_as_float(v << 16); }
__device__ __forceinline__ float bfhi(unsigned v) { return __uint_as_float(v & 0xffff0000u); }
typedef __bf16 bf16x2_t __attribute__((ext_vector_type(2)));
__device__ __forceinline__ unsigned pk2(float lo, float hi) { bf16x2_t v = {(__bf16)lo, (__bf16)hi}; return __builtin_bit_cast(unsigned, v); }
__device__ __forceinline__ bf16_t f2bf(float f) { return (bf16_t)(pk2(f, 0.f) & 0xffffu); }
__device__ __forceinline__ float wave_sum(float v) {
#pragma unroll
    for (int o = 1; o < 64; o <<= 1) v += __shfl_xor(v, o);
    return v;
}
template <int CTRL> __device__ __forceinline__ float dppf(float x) { return __builtin_bit_cast(float, __builtin_amdgcn_update_dpp(0, __builtin_bit_cast(int, x), CTRL, 0xF, 0xF, true)); }
__device__ __forceinline__ float row16_sum(float x) { x += dppf<0xB1>(x); x += dppf<0x4E>(x); x += dppf<0x141>(x); x += dppf<0x140>(x); return x; }
__device__ __forceinline__ void row16_sum2(float& x, float& y) {
    x += dppf<0xB1>(x); y += dppf<0xB1>(y); x += dppf<0x4E>(x); y += dppf<0x4E>(y); x += dppf<0x141>(x); y += dppf<0x141>(y); x += dppf<0x140>(x); y += dppf<0x140>(y);
}
__device__ __forceinline__ float row16_max(float x) { x = fmaxf(x, dppf<0xB1>(x)); x = fmaxf(x, dppf<0x4E>(x)); x = fmaxf(x, dppf<0x141>(x)); x = fmaxf(x, dppf<0x140>(x)); return x; }
__device__ __forceinline__ float softplusf(float x) { return fmaxf(x, 0.f) + __logf(1.f + __expf(-fabsf(x))); }
__device__ __forceinline__ float sigmoidf_(float x) { return __builtin_amdgcn_rcpf(1.f + __expf(-x)); }
__device__ __forceinline__ float siluf_(float x) { return x * __builtin_amdgcn_rcpf(1.f + __expf(-x)); }
__device__ __forceinline__ f32x4 mfma16(bf16x8 a, bf16x8 b, f32x4 c) { return __builtin_amdgcn_mfma_f32_16x16x32_bf16(a, b, c, 0, 0, 0); }

template <int NF, int KT, bool TRANS>
__device__ __forceinline__ void wave_mma(f32x4 (&acc)[NF], const bf16_t* A, int sa, const bf16_t* B, int sb, int fr, int fq) {
#pragma unroll
    for (int k = 0; k < KT; k += 32) {
        const bf16x8 av = *(const bf16x8*)(A + fr * sa + k + 8 * fq);
#pragma unroll
        for (int f = 0; f < NF; ++f) {
            const bf16x8 bv = *(const bf16x8*)(B + (16 * f + fr) * sb + k + 8 * fq);
            acc[f] = TRANS ? mfma16(bv, av, acc[f]) : mfma16(av, bv, acc[f]);
        }
    }
}

namespace pg8 {
constexpr int BM = 256, BK = 64, HALF = 128, HTB = HALF * BK * 2, STAGE_BYTES = 8 * HTB, NXCD = 8, WGM = 4;
__device__ __forceinline__ int lds_byte(int r, int c) { const int st = (r >> 4) * 2 + (c >> 5), rr = r & 15, cc = c & 31, ob = rr * 64 + cc * 2; return st * 1024 + (ob ^ (((ob >> 9) & 1) << 5)); }
__device__ __forceinline__ void stage_rc(int b, int& R, int& C) { const int st = b / 1024, sb = b % 1024, swz = sb ^ (((sb >> 9) & 1) << 5); R = (st >> 1) * 16 + swz / 64; C = (st & 1) * 32 + (swz % 64) / 2; }
__device__ __forceinline__ int perm32(int rho) { const int n = rho >> 4, i = rho & 15; return 8 * (i >> 2) + 4 * n + (i & 3); }
struct Unit { int pm, pn; };
struct Gemm { const bf16_t* A; const bf16_t* Bt; int M, N, K; };
struct StaticOrder {
    int nM, nN, nwg, G, c;
    __device__ void init(int M, int N, int G_, int c_) { nM = M / BM; nN = N / BM; nwg = nM * nN; G = G_; c = c_; }
    __device__ bool next(int i, Unit& u) const {
        const long L = (long)i * G + c; if (L >= nwg) return false;
        int wgid = (int)L; { const int q = nwg / NXCD, r = nwg % NXCD, xcd = wgid % NXCD, off = wgid / NXCD; wgid = (xcd < r ? xcd * (q + 1) : r * (q + 1) + (xcd - r) * q) + off; }
        const int nig = WGM * nN, gid = wgid / nig, fm = gid * WGM, gsz = (nM - fm) < WGM ? (nM - fm) : WGM;
        u.pm = fm + ((wgid % nig) % gsz); u.pn = (wgid % nig) / gsz; return true;
    }
};
struct EpiBf16 {
    static constexpr bool PERM = true;
    bf16_t* O; int ldc; int act; const float* ss;
    __device__ __forceinline__ void operator()(const f32x4 (&acc)[2][2][4][2], const Unit& u, int wr, int wc, int fr, int fq) const {
        const int row0 = u.pm * BM + wr * 64 + fr, col0 = u.pn * BM + wc * 32 + 8 * fq;
#pragma unroll
        for (int ai = 0; ai < 2; ++ai)
#pragma unroll
            for (int m = 0; m < 4; ++m) { const int row = row0 + ai * HALF + m * 16; bf16_t* rowp = O + (size_t)row * ldc + col0;
                const float rs = ss ? rsqrtf(ss[row] * (1.f / 2048.f) + 1e-6f) : 1.f;
#pragma unroll
                for (int bj = 0; bj < 2; ++bj) { f32x4 v0 = acc[ai][bj][m][0] * rs, v1 = acc[ai][bj][m][1] * rs;
                    if (act == 1) {
#pragma unroll
                        for (int j = 0; j < 4; ++j) { const float a0 = fmaxf(v0[j], 0.f), a1 = fmaxf(v1[j], 0.f); v0[j] = a0 * a0; v1[j] = a1 * a1; } }
                    u32x4 w; w.x = pk2(v0[0], v0[1]); w.y = pk2(v0[2], v0[3]); w.z = pk2(v1[0], v1[1]); w.w = pk2(v1[2], v1[3]);
                    *(u32x4*)(rowp + bj * HALF) = w; } }
    }
};
template <bool BASE_BF16> struct EpiResBf16 {
    static constexpr bool PERM = true;
    const void* base; bf16_t* out; int ldc; float* ss;
    __device__ __forceinline__ void operator()(const f32x4 (&acc)[2][2][4][2], const Unit& u, int wr, int wc, int fr, int fq) const {
        const int row0 = u.pm * BM + wr * 64 + fr, col0 = u.pn * BM + wc * 32 + 8 * fq;
#pragma unroll
        for (int ai = 0; ai < 2; ++ai)
#pragma unroll
            for (int m = 0; m < 4; ++m) { const int row = row0 + ai * HALF + m * 16; const size_t off = (size_t)row * ldc + col0; float sq = 0.f;
#pragma unroll
                for (int bj = 0; bj < 2; ++bj) { f32x4 b0, b1;
                    if (BASE_BF16) { const u32x4 r = *(const u32x4*)((const bf16_t*)base + off + bj * HALF); b0 = (f32x4){bflo(r.x), bfhi(r.x), bflo(r.y), bfhi(r.y)}; b1 = (f32x4){bflo(r.z), bfhi(r.z), bflo(r.w), bfhi(r.w)}; }
                    else { b0 = __builtin_nontemporal_load((const f32x4*)((const float*)base + off + bj * HALF)); b1 = __builtin_nontemporal_load((const f32x4*)((const float*)base + off + bj * HALF + 4)); }
                    const f32x4 v0 = b0 + acc[ai][bj][m][0], v1 = b1 + acc[ai][bj][m][1];
                    sq += (v0[0] * v0[0] + v0[1] * v0[1]) + (v0[2] * v0[2] + v0[3] * v0[3]) + (v1[0] * v1[0] + v1[1] * v1[1]) + (v1[2] * v1[2] + v1[3] * v1[3]);
                    u32x4 w; w.x = pk2(v0[0], v0[1]); w.y = pk2(v0[2], v0[3]); w.z = pk2(v1[0], v1[1]); w.w = pk2(v1[2], v1[3]);
                    *(u32x4*)(out + off + bj * HALF) = w; }
                sq += __shfl_xor(sq, 16); sq += __shfl_xor(sq, 32);
                if (fq == 0) atomicAdd(ss + row, sq); }
    }
};
struct EpiResF32 {
    static constexpr bool PERM = true;
    const bf16_t* base; float* out; int ldc;
    __device__ __forceinline__ void operator()(const f32x4 (&acc)[2][2][4][2], const Unit& u, int wr, int wc, int fr, int fq) const {
        const int row0 = u.pm * BM + wr * 64 + fr, col0 = u.pn * BM + wc * 32 + 8 * fq;
#pragma unroll
        for (int ai = 0; ai < 2; ++ai)
#pragma unroll
            for (int m = 0; m < 4; ++m) { const size_t off = (size_t)(row0 + ai * HALF + m * 16) * ldc + col0;
#pragma unroll
                for (int bj = 0; bj < 2; ++bj) { const u32x4 r = *(const u32x4*)(base + off + bj * HALF);
                    const f32x4 b0 = (f32x4){bflo(r.x), bfhi(r.x), bflo(r.y), bfhi(r.y)}, b1 = (f32x4){bflo(r.z), bfhi(r.z), bflo(r.w), bfhi(r.w)};
                    *(f32x4*)(out + off + bj * HALF) = b0 + acc[ai][bj][m][0]; *(f32x4*)(out + off + bj * HALF + 4) = b1 + acc[ai][bj][m][1]; } }
    }
};
struct EpiLora {
    static constexpr bool PERM = true;
    bf16_t *E, *A, *G; const float *w0, *a0;
    template <int GRP>
    __device__ __forceinline__ void store(const f32x4 (&acc)[2][2][4][2], bf16_t* O, const float* bp, int row0, int col0) const {
        f32x4 bv[2][2];
#pragma unroll
        for (int bj = 0; bj < 2; ++bj)
#pragma unroll
            for (int n = 0; n < 2; ++n) bv[bj][n] = GRP == 2 ? (f32x4){0.f, 0.f, 0.f, 0.f} : *(const f32x4*)(bp + col0 + bj * HALF + 4 * n);
#pragma unroll
        for (int ai = 0; ai < 2; ++ai)
#pragma unroll
            for (int m = 0; m < 4; ++m) { bf16_t* rowp = O + (size_t)(row0 + ai * HALF + m * 16) * 1024 + col0;
#pragma unroll
                for (int bj = 0; bj < 2; ++bj) { f32x4 v0 = acc[ai][bj][m][0] + bv[bj][0], v1 = acc[ai][bj][m][1] + bv[bj][1];
                    if (GRP == 0) {
#pragma unroll
                        for (int j = 0; j < 4; ++j) { v0[j] = __expf(-softplusf(-v0[j]) - 0.5f); v1[j] = __expf(-softplusf(-v1[j]) - 0.5f); }
                    } else if (GRP == 1) {
#pragma unroll
                        for (int j = 0; j < 4; ++j) { v0[j] = sigmoidf_(v0[j]); v1[j] = sigmoidf_(v1[j]); }
                    }
                    u32x4 w; w.x = pk2(v0[0], v0[1]); w.y = pk2(v0[2], v0[3]); w.z = pk2(v1[0], v1[1]); w.w = pk2(v1[2], v1[3]);
                    *(u32x4*)(rowp + bj * HALF) = w; } }
    }
    __device__ __forceinline__ void operator()(const f32x4 (&acc)[2][2][4][2], const Unit& u, int wr, int wc, int fr, int fq) const {
        const int grp = u.pn >> 2;
        const int row0 = u.pm * BM + wr * 64 + fr, col0 = (u.pn & 3) * BM + wc * 32 + 8 * fq;
        if (grp == 0) store<0>(acc, E, w0, row0, col0);
        else if (grp == 1) store<1>(acc, A, a0, row0, col0);
        else store<2>(acc, G, a0, row0, col0);
    }
};

template <class Epi>
__device__ __forceinline__ void gemm_phase(LAS unsigned char* lds, const Gemm g, const StaticOrder& S, const Epi& E) {
    const int tid = threadIdx.x, wid = __builtin_amdgcn_readfirstlane(tid >> 6), lane = tid & 63, wr = wid >> 2, wc = wid & 3, fr = lane & 15, fq = lane >> 4;
    const int K = g.K, nt = K / BK;
    unsigned voffA[2], voffB[2];
#pragma unroll
    for (int i = 0; i < 2; ++i) { int R, C; stage_rc(tid * 16 + i * 8192, R, C); const int Rb = Epi::PERM ? ((R & ~31) + perm32(R & 31)) : R;
        voffA[i] = (unsigned)(R * K + C) * 2u; voffB[i] = (unsigned)(Rb * K + C) * 2u; }
    const size_t kstep = (size_t)(BK * 2);
    const size_t hstep = (size_t)HALF * K * 2;
    const size_t tstep = 2 * hstep;
    const unsigned ldsw = (unsigned)wid * 1024u;
    const int aoff = lds_byte(wr * 64 + fr, fq * 8), boff = lds_byte(wc * 32 + fr, fq * 8);
#define PG8_SA(b, h) (((b) * 2 + (h)) * HTB)
#define PG8_SB(b, h) ((4 + (b) * 2 + (h)) * HTB)
#define PG8_STAGE(bufoff, gbase, voff) do { _Pragma("unroll") for (int _i = 0; _i < 2; ++_i) \
        __builtin_amdgcn_global_load_lds((const unsigned*)((const char*)(gbase) + (voff)[_i]), (LAS unsigned*)(lds + (bufoff) + ldsw + _i * 8192), 16, 0, 0); } while (0)
#define PG8_LDA(dst, b, h) do { _Pragma("unroll") for (int m = 0; m < 4; ++m) _Pragma("unroll") for (int k = 0; k < 2; ++k) dst[m][k] = *(const LAS bf16x8*)(lds + PG8_SA(b, h) + aoff + m * 2048 + k * 1024); } while (0)
#define PG8_LDB(dst, b, h) do { _Pragma("unroll") for (int n = 0; n < 2; ++n) _Pragma("unroll") for (int k = 0; k < 2; ++k) dst[n][k] = *(const LAS bf16x8*)(lds + PG8_SB(b, h) + boff + n * 2048 + k * 1024); } while (0)
#define PG8_MMA(ai, bj, At, Bt) do { __builtin_amdgcn_s_setprio(1); _Pragma("unroll") for (int m = 0; m < 4; ++m) _Pragma("unroll") for (int n = 0; n < 2; ++n) _Pragma("unroll") for (int k = 0; k < 2; ++k) \
        acc[ai][bj][m][n] = __builtin_amdgcn_mfma_f32_16x16x32_bf16(Bt[n][k], At[m][k], acc[ai][bj][m][n], 0, 0, 0); __builtin_amdgcn_s_setprio(0); } while (0)
#define PG8_WAIT_V(n) asm volatile("s_waitcnt vmcnt(" #n ")" ::: "memory")
#define PG8_WAIT_L(n) asm volatile("s_waitcnt lgkmcnt(" #n ")" ::: "memory")
#define PG8_BAR __builtin_amdgcn_s_barrier()
#define PG8_SCHED __builtin_amdgcn_sched_barrier(0)
    Unit cur, nxt; int ui = 0;
    if (!S.next(0, cur)) return;
    f32x4 acc[2][2][4][2];
#pragma unroll
    for (int a = 0; a < 2; ++a)
#pragma unroll
        for (int b = 0; b < 2; ++b)
#pragma unroll
            for (int m = 0; m < 4; ++m)
#pragma unroll
                for (int n = 0; n < 2; ++n) acc[a][b][m][n] = (f32x4){0.f, 0.f, 0.f, 0.f};
    bf16x8 At[4][2], B0[2][2], B1[2][2];
    const char* cA = (const char*)g.A + (size_t)cur.pm * tstep; const char* cB = (const char*)g.Bt + (size_t)cur.pn * tstep;
    PG8_STAGE(PG8_SB(0, 0), cB, voffB); PG8_STAGE(PG8_SA(0, 0), cA, voffA); PG8_STAGE(PG8_SB(0, 1), cB + hstep, voffB); PG8_STAGE(PG8_SA(0, 1), cA + hstep, voffA);
    if (wr == 1) PG8_BAR;
    PG8_WAIT_V(4); PG8_BAR;
    PG8_STAGE(PG8_SB(1, 0), cB + kstep, voffB); PG8_STAGE(PG8_SA(1, 0), cA + kstep, voffA); PG8_STAGE(PG8_SB(1, 1), cB + hstep + kstep, voffB);
    PG8_WAIT_V(6); PG8_BAR;
    for (;;) {
        const bool has_next = S.next(ui + 1, nxt);
        const char* nA = has_next ? (const char*)g.A + (size_t)nxt.pm * tstep : cA; const char* nB = has_next ? (const char*)g.Bt + (size_t)nxt.pn * tstep : cB;
        for (int t = 0; t < nt; t += 2) {
            const bool last = (t == nt - 2);
            const char* a1 = cA + (size_t)(t + 1) * kstep;
            const char* a2 = last ? nA : cA + (size_t)(t + 2) * kstep; const char* b2 = last ? nB : cB + (size_t)(t + 2) * kstep;
            const char* a3 = a2 + kstep; const char* b3 = b2 + kstep;
            PG8_LDB(B0, 0, 0); PG8_SCHED; PG8_LDA(At, 0, 0); PG8_STAGE(PG8_SA(1, 1), a1 + hstep, voffA);
            PG8_WAIT_L(8); PG8_BAR; PG8_WAIT_L(0); PG8_MMA(0, 0, At, B0); PG8_BAR; PG8_SCHED;
            PG8_LDB(B1, 0, 1); PG8_STAGE(PG8_SB(0, 0), b2, voffB);
            PG8_BAR; PG8_WAIT_L(0); PG8_MMA(0, 1, At, B1); PG8_BAR;
            PG8_LDA(At, 0, 1); PG8_STAGE(PG8_SA(0, 0), a2, voffA);
            PG8_BAR; PG8_WAIT_L(0); PG8_MMA(1, 0, At, B0); PG8_BAR; PG8_SCHED;
            PG8_STAGE(PG8_SB(0, 1), b2 + hstep, voffB);
            PG8_WAIT_V(6); PG8_BAR; PG8_MMA(1, 1, At, B1); PG8_BAR;
            PG8_LDB(B0, 1, 0); PG8_SCHED; PG8_LDA(At, 1, 0); PG8_STAGE(PG8_SA(0, 1), a2 + hstep, voffA);
            PG8_WAIT_L(8); PG8_BAR; PG8_WAIT_L(0); PG8_MMA(0, 0, At, B0); PG8_BAR; PG8_SCHED;
            PG8_LDB(B1, 1, 1); PG8_STAGE(PG8_SB(1, 0), b3, voffB);
            PG8_BAR; PG8_WAIT_L(0); PG8_MMA(0, 1, At, B1); PG8_BAR;
            PG8_LDA(At, 1, 1); PG8_STAGE(PG8_SA(1, 0), a3, voffA);
            PG8_BAR; PG8_WAIT_L(0); PG8_MMA(1, 0, At, B0); PG8_BAR; PG8_SCHED;
            PG8_STAGE(PG8_SB(1, 1), b3 + hstep, voffB);
            PG8_WAIT_V(6); PG8_BAR; PG8_MMA(1, 1, At, B1); PG8_BAR;
        }
        E(acc, cur, wr, wc, fr, fq);
        if (!has_next) break;
#pragma unroll
        for (int a = 0; a < 2; ++a)
#pragma unroll
            for (int b = 0; b < 2; ++b)
#pragma unroll
                for (int m = 0; m < 4; ++m)
#pragma unroll
                    for (int n = 0; n < 2; ++n) acc[a][b][m][n] = (f32x4){0.f, 0.f, 0.f, 0.f};
        cur = nxt; cA = nA; cB = nB; ++ui;
    }
    PG8_WAIT_V(0);
    if (wr == 0) PG8_BAR;
    PG8_BAR;
#undef PG8_SA
#undef PG8_SB
#undef PG8_STAGE
#undef PG8_LDA
#undef PG8_LDB
#undef PG8_MMA
#undef PG8_WAIT_V
#undef PG8_WAIT_L
#undef PG8_BAR
#undef PG8_SCHED
}
}

template <class Epi>
__device__ __forceinline__ void run_gemm(unsigned char* lds, const bf16_t* A, const bf16_t* Bt, int M, int N, int K, const Epi& E, int Gv = -1, int cv = 0) {
    pg8::Gemm g{A, Bt, M, N, K}; pg8::StaticOrder S; if (Gv < 0) { Gv = (int)gridDim.x; cv = (int)blockIdx.x; } S.init(M, N, Gv, cv);
    pg8::gemm_phase<Epi>((LAS unsigned char*)lds, g, S, E);
    __syncthreads();
}

__device__ __forceinline__ void transpose_item(const float* W, int K, int N, bf16_t* WT, float* scr, int item, int nblk, int lane, const float* gk = nullptr) {
    const int kb = item / nblk, nb = item % nblk, k0 = 64 * kb, n0 = 32 * nb;
    const int n = n0 + (lane & 31);
#pragma unroll
    for (int i = 0; i < 32; ++i) { const int kk = 2 * i + (lane >> 5); scr[kk * 33 + (lane & 31)] = (n < N) ? __builtin_nontemporal_load(W + (size_t)(k0 + kk) * N + n) * (gk ? gk[k0 + kk] : 1.f) : 0.f; }
    __builtin_amdgcn_fence(__ATOMIC_RELEASE, "wavefront"); __builtin_amdgcn_wave_barrier(); __builtin_amdgcn_fence(__ATOMIC_ACQUIRE, "wavefront");
    const int c = lane & 7;
#pragma unroll
    for (int j = 0; j < 4; ++j) { const int nn = (lane >> 3) + 8 * j; const float* s = scr + (8 * c) * 33 + nn;
        u32x4 o; o.x = pk2(s[0 * 33], s[1 * 33]); o.y = pk2(s[2 * 33], s[3 * 33]); o.z = pk2(s[4 * 33], s[5 * 33]); o.w = pk2(s[6 * 33], s[7 * 33]);
        *(u32x4*)(WT + (size_t)(n0 + nn) * K + k0 + 8 * c) = o; }
    __builtin_amdgcn_fence(__ATOMIC_RELEASE, "wavefront"); __builtin_amdgcn_wave_barrier(); __builtin_amdgcn_fence(__ATOMIC_ACQUIRE, "wavefront");
}
__device__ __forceinline__ void rms_row_bf16(const float* x, const float* g, bf16_t* o, int lane) {
    f32x4 v[8]; float s = 0.f;
#pragma unroll
    for (int j = 0; j < 8; ++j) { v[j] = ((const f32x4*)x)[lane + 64 * j]; s += (v[j].x * v[j].x + v[j].y * v[j].y) + (v[j].z * v[j].z + v[j].w * v[j].w); }
    const float r = rsqrtf(wave_sum(s) * (1.f / 2048.f) + 1e-6f);
#pragma unroll
    for (int j = 0; j < 8; ++j) { const f32x4 gg = ((const f32x4*)g)[lane + 64 * j]; u32x2 w; w.x = pk2(v[j].x * r * gg.x, v[j].y * r * gg.y); w.y = pk2(v[j].z * r * gg.z, v[j].w * r * gg.w); ((u32x2*)o)[lane + 64 * j] = w; }
}
__device__ __forceinline__ void rms_row_f32(float* x, const float* g, int lane) {
    f32x4 v[8]; float s = 0.f;
#pragma unroll
    for (int j = 0; j < 8; ++j) { v[j] = ((const f32x4*)x)[lane + 64 * j]; s += (v[j].x * v[j].x + v[j].y * v[j].y) + (v[j].z * v[j].z + v[j].w * v[j].w); }
    const float r = rsqrtf(wave_sum(s) * (1.f / 2048.f) + 1e-6f);
#pragma unroll
    for (int j = 0; j < 8; ++j) { const f32x4 gg = ((const f32x4*)g)[lane + 64 * j]; ((f32x4*)x)[lane + 64 * j] = v[j] * r * gg; }
}
__device__ __forceinline__ void norm_rows_bf16(const float* X, const float* g, bf16_t* O, int rows) {
    const int lane = threadIdx.x & 63, gw = blockIdx.x * 8 + (threadIdx.x >> 6), NGW = gridDim.x * 8;
    int m = gw;
    for (; m + NGW < rows; m += 2 * NGW) {
        const float* xa = X + (size_t)m * DM; const float* xb = X + (size_t)(m + NGW) * DM;
        f32x4 va[8], vb[8]; float sa = 0.f, sb = 0.f;
#pragma unroll
        for (int j = 0; j < 8; ++j) { va[j] = __builtin_nontemporal_load((const f32x4*)xa + lane + 64 * j); vb[j] = __builtin_nontemporal_load((const f32x4*)xb + lane + 64 * j); }
#pragma unroll
        for (int j = 0; j < 8; ++j) { sa += (va[j].x * va[j].x + va[j].y * va[j].y) + (va[j].z * va[j].z + va[j].w * va[j].w); sb += (vb[j].x * vb[j].x + vb[j].y * vb[j].y) + (vb[j].z * vb[j].z + vb[j].w * vb[j].w); }
#pragma unroll
        for (int o = 1; o < 64; o <<= 1) { sa += __shfl_xor(sa, o); sb += __shfl_xor(sb, o); }
        const float ra = rsqrtf(sa * (1.f / 2048.f) + 1e-6f), rb = rsqrtf(sb * (1.f / 2048.f) + 1e-6f);
        u32x2* oa = (u32x2*)(O + (size_t)m * DM); u32x2* ob = (u32x2*)(O + (size_t)(m + NGW) * DM);
#pragma unroll
        for (int j = 0; j < 8; ++j) { const f32x4 gg = ((const f32x4*)g)[lane + 64 * j];
            u32x2 wa; wa.x = pk2(va[j].x * ra * gg.x, va[j].y * ra * gg.y); wa.y = pk2(va[j].z * ra * gg.z, va[j].w * ra * gg.w); oa[lane + 64 * j] = wa;
            u32x2 wb; wb.x = pk2(vb[j].x * rb * gg.x, vb[j].y * rb * gg.y); wb.y = pk2(vb[j].z * rb * gg.z, vb[j].w * rb * gg.w); ob[lane + 64 * j] = wb; }
    }
    for (; m < rows; m += NGW) rms_row_bf16(X + (size_t)m * DM, g, O + (size_t)m * DM, lane);
}

__device__ __forceinline__ void p0_prologue(const Args& a, unsigned char* lds) {
    const int tid = threadIdx.x, lane = tid & 63, wave = tid >> 6;
    float* scr = (float*)(lds + wave * 8448);
    const int gw = blockIdx.x * 8 + wave, NGW = gridDim.x * 8;
    unsigned char* ws = a.ws;
    constexpr int I_IN = 32 * 192, I_SQ = 32 * 64;
    constexpr int NITEMS = I_IN + 2 * I_SQ;
    for (int it = gw; it < NITEMS; it += NGW) {
        int r = it;
        if (r < I_IN) { transpose_item(a.in[3], DM, 6096, (bf16_t*)(ws + WS_WIN), scr, r, 192, lane); continue; } r -= I_IN;
        if (r < I_SQ) { transpose_item(a.in[25], DM, DM, (bf16_t*)(ws + WS_WK), scr, r, 64, lane); continue; } r -= I_SQ;
        transpose_item(a.in[26], DM, DM, (bf16_t*)(ws + WS_WV), scr, r, 64, lane);
    }
    {
        bf16_t* LT = (bf16_t*)(ws + WS_LORA); const float *w2 = a.in[12], *a2 = a.in[14], *g2 = a.in[15];
        for (int idx = blockIdx.x * 512 + tid; idx < 3072 * 512; idx += gridDim.x * 512) {
            const int n = idx >> 9, k = idx & 511, grp = n >> 10, nn = n & 1023; float v = 0.f;
            if (grp == 0) { if (k < 96) v = w2[k * 1024 + nn]; }
            else if (grp == 1) { if (k >= 96 && k < 192) v = a2[(k - 96) * 1024 + nn]; }
            else { if (k >= 192 && k < 448) v = g2[(k - 192) * 1024 + nn]; }
            LT[idx] = f2bf(v);
        }
    }
    { float* ssz = (float*)(ws + WS_SS); for (int i = blockIdx.x * 512 + tid; i < 3 * T_TOK; i += gridDim.x * 512) ssz[i] = 0.f; }
    norm_rows_bf16(a.in[0], a.in[2], (bf16_t*)(ws + WS_HN), T_TOK);
    norm_rows_bf16(a.in[1], a.in[23], (bf16_t*)(ws + WS_MN), 1024);
}

__device__ __forceinline__ void unpack8(const u32x4 u, float (&f)[8]) { f[0] = bflo(u.x); f[1] = bfhi(u.x); f[2] = bflo(u.y); f[3] = bfhi(u.y); f[4] = bflo(u.z); f[5] = bfhi(u.z); f[6] = bflo(u.w); f[7] = bfhi(u.w); }
__device__ __forceinline__ void lora_prep(const Args& a) {
    const bf16_t* U = (const bf16_t*)(a.ws + WS_U); bf16_t* LA = (bf16_t*)((unsigned char*)a.out + DO_LA); const float* mu = a.in[10];
#pragma unroll 2
    for (int idx = blockIdx.x * 512 + threadIdx.x; idx < T_TOK * 64; idx += gridDim.x * 512) {
        const int t = idx >> 6, c = (idx & 63) * 8; u32x4 w = (u32x4){0u, 0u, 0u, 0u};
        if (c < 448) {
            const bf16_t* up = U + (size_t)t * NU + 5648 + c;
            const u32x4 cu = *(const u32x4*)up; u32x4 pv = (u32x4){0u, 0u, 0u, 0u}; if (t & (SEQ - 1)) pv = *(const u32x4*)(up - NU);
            const f32x4 m0 = *(const f32x4*)(mu + 3072 + c), m1 = *(const f32x4*)(mu + 3072 + c + 4);
            float cur[8], prv[8], v[8]; unpack8(cu, cur); unpack8(pv, prv);
            const float mm[8] = {m0.x, m0.y, m0.z, m0.w, m1.x, m1.y, m1.z, m1.w};
#pragma unroll
            for (int j = 0; j < 8; ++j) { const float x = cur[j] + (prv[j] - cur[j]) * mm[j]; v[j] = c < 96 ? tanhf(x) : (c < 192 ? x : sigmoidf_(x)); }
            w.x = pk2(v[0], v[1]); w.y = pk2(v[2], v[3]); w.z = pk2(v[4], v[5]); w.w = pk2(v[6], v[7]);
        }
        *(u32x4*)(LA + (size_t)t * 512 + c) = w;
    }
}


__device__ __forceinline__ void ssd_passA(const Args& a, unsigned char* lds, int item) {
    const int tid = threadIdx.x, lane = tid & 63, wid = tid >> 6, fr = lane & 15, fq = lane >> 4;
    const int g = item & 1, c = (item >> 1) & 31, b = item >> 6;
    const int t0 = b * SEQ + c * 128;
    const bf16_t* U = (const bf16_t*)(a.ws + WS_U);
    unsigned char* dob = (unsigned char*)a.out;
    bf16_t* ST = (bf16_t*)(dob + DO_ST); bf16_t* XC = (bf16_t*)(dob + DO_XC); float* DT = (float*)(dob + DO_DT); float* CS = (float*)(dob + DO_CS);
    float* CD = (float*)(a.ws + WS_CD);
    float* dtl = (float*)lds; float* csl = dtl + 1024;
    bf16_t* BT = (bf16_t*)(lds + 8192); bf16_t* XT = BT + 128 * 136;
    const float* conv_w = a.in[4]; const float* conv_b = a.in[5];
    for (int idx = tid; idx < 1024; idx += 512) { const int e = idx >> 7, s = idx & 127, h = g * 8 + e;
        const float x = bf2f(U[(size_t)(t0 + s) * NU + 2560 + h]) + a.in[6][h]; const float dt = softplusf(x);
        dtl[idx] = dt; csl[idx] = dt * (-__expf(a.in[7][h])); }
    __syncthreads();
    { const int e = wid; const float v0 = csl[e * 128 + 2 * lane], v1 = csl[e * 128 + 2 * lane + 1]; float sum = v0 + v1;
#pragma unroll
      for (int off = 1; off < 64; off <<= 1) { const float n = __shfl_up(sum, off); if (lane >= off) sum += n; }
      const float excl = sum - (v0 + v1); csl[e * 128 + 2 * lane] = excl + v0; csl[e * 128 + 2 * lane + 1] = excl + v0 + v1; }
    __syncthreads();
    for (int idx = tid; idx < 1024; idx += 512) { const int e = idx >> 7, s = idx & 127, h = g * 8 + e; DT[(size_t)(t0 + s) * 16 + h] = dtl[idx]; CS[(size_t)(t0 + s) * 16 + h] = csl[idx]; }
    if (tid < 8) CD[(b * 32 + c) * 16 + g * 8 + tid] = __expf(csl[tid * 128 + 127]);
    for (int half = 0; half < 2; ++half) {
        const int ngroups = half ? 32 : 64, seglen = half ? 8 : 16;
        const int gi = tid % ngroups, seg = tid / ngroups;
        int col, kind;
        if (!half) { if (gi < 16) { col = 2048 + g * 128 + gi * 8; kind = 0; } else if (gi < 32) { col = 2304 + g * 128 + (gi - 16) * 8; kind = 1; } else { col = 1024 + g * 512 + (gi - 32) * 8; kind = 2; } }
        else { col = 1024 + g * 512 + 256 + gi * 8; kind = 2; }
        const int cc = col - 1024;
        float w0[8], w1[8], w2[8], w3[8], bb[8], x1[8], x2[8], x3[8], cur[8];
#pragma unroll
        for (int j = 0; j < 8; ++j) { w0[j] = conv_w[0 * 1536 + cc + j]; w1[j] = conv_w[1 * 1536 + cc + j]; w2[j] = conv_w[2 * 1536 + cc + j]; w3[j] = conv_w[3 * 1536 + cc + j]; bb[j] = conv_b[cc + j]; }
        const int s0 = seg * seglen;
        {
            const int sp = c * 128 + s0;
            const u32x4 z4 = (u32x4){0u, 0u, 0u, 0u};
            const u32x4 r1 = sp >= 3 ? *(const u32x4*)(U + (size_t)(t0 + s0 - 3) * NU + col) : z4;
            const u32x4 r2 = sp >= 2 ? *(const u32x4*)(U + (size_t)(t0 + s0 - 2) * NU + col) : z4;
            const u32x4 r3 = sp >= 1 ? *(const u32x4*)(U + (size_t)(t0 + s0 - 1) * NU + col) : z4;
            unpack8(r1, x1); unpack8(r2, x2); unpack8(r3, x3);
        }
        const int chg = cc - g * 512;
        const int e = (chg >> 6) & 7, eh = e & 3, p0 = chg & 63;
        for (int i = 0; i < seglen; ++i) {
            const int s = s0 + i;
            const u32x4 rc = *(const u32x4*)(U + (size_t)(t0 + s) * NU + col); unpack8(rc, cur);
            float v[8];
#pragma unroll
            for (int j = 0; j < 8; ++j) { const float o = bb[j] + w0[j] * x1[j] + w1[j] * x2[j] + w2[j] * x3[j] + w3[j] * cur[j]; v[j] = siluf_(o); x1[j] = x2[j]; x2[j] = x3[j]; x3[j] = cur[j]; }
            u32x4 w; w.x = pk2(v[0], v[1]); w.y = pk2(v[2], v[3]); w.z = pk2(v[4], v[5]); w.w = pk2(v[6], v[7]);
            *(u32x4*)(XC + (size_t)(t0 + s) * 1536 + cc) = w;
            if (kind == 0) {
#pragma unroll
                for (int j = 0; j < 8; ++j) BT[(gi * 8 + j) * 136 + s] = f2bf(v[j]);
            } else if (kind == 2) {
                const float sc = dtl[e * 128 + s] * __expf(csl[e * 128 + 127] - csl[e * 128 + s]);
#pragma unroll
                for (int j = 0; j < 8; ++j) XT[(eh * 64 + p0 + j) * 136 + s] = f2bf(v[j] * sc);
            }
        }
        __syncthreads();
        {
            const int eh2 = wid >> 1, nh = wid & 1, h = g * 8 + half * 4 + eh2;
            bf16_t* dst = ST + (size_t)((b * 32 + c) * 16 + h) * 8192;
#pragma unroll 1
            for (int rb = 0; rb < 4; ++rb) {
                f32x4 acc[4];
#pragma unroll
                for (int f = 0; f < 4; ++f) acc[f] = (f32x4){0.f, 0.f, 0.f, 0.f};
                wave_mma<4, 128, true>(acc, XT + (eh2 * 64 + rb * 16) * 136, 136, BT + (nh * 64) * 136, 136, fr, fq);
                const int p = rb * 16 + fr;
#pragma unroll
                for (int f = 0; f < 4; ++f) { u32x2 w; w.x = pk2(acc[f][0], acc[f][1]); w.y = pk2(acc[f][2], acc[f][3]); *(u32x2*)(dst + p * 128 + nh * 64 + 16 * f + 4 * fq) = w; }
            }
        }
        __syncthreads();
    }
}

__device__ __forceinline__ void ssd_state_scan(const Args& a) {
    bf16_t* ST = (bf16_t*)((unsigned char*)a.out + DO_ST); const float* CD = (const float*)(a.ws + WS_CD);
    for (int idx = blockIdx.x * 512 + threadIdx.x; idx < 4 * 16 * 2048; idx += gridDim.x * 512) {
        const int el = idx & 2047, h = (idx >> 11) & 15, b = idx >> 15;
        bf16_t* p0 = ST + (size_t)(b * 32 * 16 + h) * 8192 + el * 4;
        float h0 = 0.f, h1 = 0.f, h2 = 0.f, h3 = 0.f;
#pragma unroll 1
        for (int cb = 0; cb < 32; cb += 8) {
            u32x2 sv[8]; float dec[8];
#pragma unroll
            for (int c = 0; c < 8; ++c) { sv[c] = *(const u32x2*)(p0 + (size_t)(cb + c) * 16 * 8192); dec[c] = CD[(b * 32 + cb + c) * 16 + h]; }
#pragma unroll
            for (int c = 0; c < 8; ++c) {
                u32x2 w; w.x = pk2(h0, h1); w.y = pk2(h2, h3);
                *(u32x2*)(p0 + (size_t)(cb + c) * 16 * 8192) = w;
                h0 = h0 * dec[c] + bflo(sv[c].x); h1 = h1 * dec[c] + bfhi(sv[c].x); h2 = h2 * dec[c] + bflo(sv[c].y); h3 = h3 * dec[c] + bfhi(sv[c].y);
            }
        }
    }
}

__device__ __forceinline__ void ssd_passC(const Args& a, unsigned char* lds, int item) {
    const int tid = threadIdx.x, lane = tid & 63, wid = tid >> 6, fr = lane & 15, fq = lane >> 4;
    const int g = item & 1, c = (item >> 1) & 31, b = item >> 6;
    const int t0 = b * SEQ + c * 128;
    const bf16_t* U = (const bf16_t*)(a.ws + WS_U);
    unsigned char* dob = (unsigned char*)a.out;
    const bf16_t* ST = (const bf16_t*)(dob + DO_ST); const bf16_t* XC = (const bf16_t*)(dob + DO_XC); const float* DT = (const float*)(dob + DO_DT); const float* CS = (const float*)(dob + DO_CS);
    bf16_t* YM = (bf16_t*)(a.ws + WS_HN);
    float* dtl = (float*)lds; float* csl = dtl + 1024;
    bf16_t* Cn = (bf16_t*)(lds + 8192); bf16_t* Bn = Cn + 128 * 136; bf16_t* XdT = Bn + 128 * 136; bf16_t* StL = XdT + 64 * 136;
    bf16_t* Ml = Bn;
    for (int idx = tid; idx < 1024; idx += 512) { const int e = idx >> 7, s = idx & 127; dtl[idx] = DT[(size_t)(t0 + s) * 16 + g * 8 + e]; csl[idx] = CS[(size_t)(t0 + s) * 16 + g * 8 + e]; }
    for (int idx = tid; idx < 2048; idx += 512) { const int r = idx >> 4, ch = idx & 15;
        *(u32x4*)(Cn + r * 136 + ch * 8) = __builtin_nontemporal_load((const u32x4*)(XC + (size_t)(t0 + r) * 1536 + 1280 + g * 128 + ch * 8));
        *(u32x4*)(Bn + r * 136 + ch * 8) = __builtin_nontemporal_load((const u32x4*)(XC + (size_t)(t0 + r) * 1536 + 1024 + g * 128 + ch * 8)); }
    __syncthreads();
    f32x4 cb[8];
#pragma unroll
    for (int f = 0; f < 8; ++f) cb[f] = (f32x4){0.f, 0.f, 0.f, 0.f};
    wave_mma<8, 128, false>(cb, Cn + (16 * wid) * 136, 136, Bn, 136, fr, fq);
    __syncthreads();
    float ssum = 0.f;
    const int lrow = 16 * wid + fr;
#pragma unroll 1
    for (int e = 0; e < 8; ++e) {
        const int h = g * 8 + e;
#pragma unroll
        for (int f = 0; f < 8; ++f)
#pragma unroll
            for (int j = 0; j < 4; ++j) { const int l = 16 * wid + 4 * fq + j, s = 16 * f + fr;
                const float m = (s <= l) ? cb[f][j] * __expf(csl[e * 128 + l] - csl[e * 128 + s]) : 0.f;
                Ml[l * 136 + s] = f2bf(m); }
        { const int s = tid & 127, pg = tid >> 7; const bf16_t* src = XC + (size_t)(t0 + s) * 1536 + g * 512 + e * 64 + pg * 16;
          const u32x4 r0 = *(const u32x4*)src, r1 = *(const u32x4*)(src + 8); float x0[8], x1[8]; unpack8(r0, x0); unpack8(r1, x1);
          const float dts = dtl[e * 128 + s];
#pragma unroll
          for (int j = 0; j < 8; ++j) { XdT[(pg * 16 + j) * 136 + s] = f2bf(x0[j] * dts); XdT[(pg * 16 + 8 + j) * 136 + s] = f2bf(x1[j] * dts); } }
        { const bf16_t* src = ST + (size_t)((b * 32 + c) * 16 + h) * 8192;
          for (int idx = tid; idx < 1024; idx += 512) { const int r = idx >> 4, ch = idx & 15; *(u32x4*)(StL + r * 136 + ch * 8) = __builtin_nontemporal_load((const u32x4*)(src + r * 128 + ch * 8)); } }
        __syncthreads();
        f32x4 yd[4], yo[4];
#pragma unroll
        for (int f = 0; f < 4; ++f) { yd[f] = (f32x4){0.f, 0.f, 0.f, 0.f}; yo[f] = (f32x4){0.f, 0.f, 0.f, 0.f}; }
        wave_mma<4, 128, true>(yd, Ml + (16 * wid) * 136, 136, XdT, 136, fr, fq);
        wave_mma<4, 128, true>(yo, Cn + (16 * wid) * 136, 136, StL, 136, fr, fq);
        const float ecs = __expf(csl[e * 128 + lrow]), Dh = a.in[8][h];
#pragma unroll
        for (int f = 0; f < 4; ++f) { const int ch = g * 512 + e * 64 + 16 * f + 4 * fq;
            const u32x2 xr = *(const u32x2*)(XC + (size_t)(t0 + lrow) * 1536 + ch); const u32x2 zr = *(const u32x2*)(U + (size_t)(t0 + lrow) * NU + ch);
            const float xs[4] = {bflo(xr.x), bfhi(xr.x), bflo(xr.y), bfhi(xr.y)}; const float zz[4] = {bflo(zr.x), bfhi(zr.x), bflo(zr.y), bfhi(zr.y)};
            float y[4];
#pragma unroll
            for (int j = 0; j < 4; ++j) { y[j] = (yd[f][j] + ecs * yo[f][j] + xs[j] * Dh) * siluf_(zz[j]); ssum += y[j] * y[j]; }
            u32x2 w; w.x = pk2(y[0], y[1]); w.y = pk2(y[2], y[3]);
            *(u32x2*)(YM + (size_t)(t0 + lrow) * DM + ch) = w; }
        __syncthreads();
    }
    ssum += __shfl_xor(ssum, 16); ssum += __shfl_xor(ssum, 32);
    const float rstd = rsqrtf(ssum * (1.f / 512.f) + 1e-6f);
    const float* ng = a.in[9];
#pragma unroll 1
    for (int e = 0; e < 8; ++e)
#pragma unroll
        for (int f = 0; f < 4; ++f) { const int ch = g * 512 + e * 64 + 16 * f + 4 * fq; bf16_t* p = YM + (size_t)(t0 + lrow) * DM + ch;
            const u32x2 yr = *(const u32x2*)p; const f32x4 gg = *(const f32x4*)(ng + ch);
            u32x2 w; w.x = pk2(bflo(yr.x) * rstd * gg.x, bfhi(yr.x) * rstd * gg.y); w.y = pk2(bflo(yr.y) * rstd * gg.z, bfhi(yr.y) * rstd * gg.w);
            *(u32x2*)p = w; }
    __syncthreads();
}

constexpr int LATE_SQ = 32 * 64, LATE_1 = 32 * 256, LATE_2 = 128 * 64, LATE_ITEMS = 3 * LATE_SQ + LATE_1 + LATE_2;
struct LateTile { const float* W; bf16_t* WT; const float* gk; int K, N, k0, n0; };
__device__ __forceinline__ LateTile late_decode(const Args& a, int it) {
    unsigned char* ws = a.ws; LateTile d; d.gk = nullptr; int r = it, nblk;
    if (r < LATE_SQ) { d.W = a.in[21]; d.WT = (bf16_t*)(ws + WS_WOUT); d.K = DM; d.N = DM; nblk = 64; }
    else if ((r -= LATE_SQ) < LATE_SQ) { d.W = a.in[24]; d.WT = (bf16_t*)(ws + WS_WQ); d.K = DM; d.N = DM; nblk = 64; d.gk = a.in[22]; }
    else if ((r -= LATE_SQ) < LATE_SQ) { d.W = a.in[27]; d.WT = (bf16_t*)(ws + WS_WO); d.K = DM; d.N = DM; nblk = 64; }
    else if ((r -= LATE_SQ) < LATE_1) { d.W = a.in[29]; d.WT = (bf16_t*)(ws + WS_W1); d.K = DM; d.N = DFF; nblk = 256; d.gk = a.in[28]; }
    else { r -= LATE_1; d.W = a.in[30]; d.WT = (bf16_t*)(ws + WS_W2); d.K = DFF; d.N = DM; nblk = 64; }
    d.k0 = 64 * (r / nblk); d.n0 = 32 * (r % nblk); return d;
}
__device__ __forceinline__ void late_load(const LateTile& d, int sub, float (&v)[8], int lane) {
#pragma unroll
    for (int i = 0; i < 8; ++i) { const int kk = d.k0 + 16 * sub + 2 * i + (lane >> 5); v[i] = __builtin_nontemporal_load(d.W + (size_t)kk * d.N + d.n0 + (lane & 31)) * (d.gk ? d.gk[kk] : 1.f); }
}
__device__ __forceinline__ void late_stash(int sub, const float (&v)[8], float* scr, int lane) {
#pragma unroll
    for (int i = 0; i < 8; ++i) scr[(16 * sub + 2 * i + (lane >> 5)) * 33 + (lane & 31)] = v[i];
}
__device__ __forceinline__ void late_flush(const LateTile& d, float* scr, int lane) {
    __builtin_amdgcn_fence(__ATOMIC_RELEASE, "wavefront"); __builtin_amdgcn_wave_barrier(); __builtin_amdgcn_fence(__ATOMIC_ACQUIRE, "wavefront");
    const int c = lane & 7;
#pragma unroll
    for (int j = 0; j < 4; ++j) { const int nn = (lane >> 3) + 8 * j; const float* s = scr + (8 * c) * 33 + nn;
        u32x4 o; o.x = pk2(s[0 * 33], s[1 * 33]); o.y = pk2(s[2 * 33], s[3 * 33]); o.z = pk2(s[4 * 33], s[5 * 33]); o.w = pk2(s[6 * 33], s[7 * 33]);
        __builtin_nontemporal_store(o, (u32x4*)(d.WT + (size_t)(d.n0 + nn) * d.K + d.k0 + 8 * c)); }
    __builtin_amdgcn_fence(__ATOMIC_RELEASE, "wavefront"); __builtin_amdgcn_wave_barrier(); __builtin_amdgcn_fence(__ATOMIC_ACQUIRE, "wavefront");
}

struct RwRaw { u32x2 rc, rp, kc, kp, vc, vp, ee, aa; };
struct RwStep { f32x4 nkk, wr, w, kka, k2; float vi; f32x2 cc; };
__device__ __forceinline__ void rw_load(RwRaw& r, const bf16_t* U, const bf16_t* Eb, const bf16_t* Ab, int b, int sp, int chn) {
    const size_t t = (size_t)b * SEQ + sp; const bf16_t* ur = U + t * NU + 2576 + chn;
    r.rc = *(const u32x2*)ur; r.kc = *(const u32x2*)(ur + 1024); r.vc = *(const u32x2*)(ur + 2048);
    if (sp > 0) { r.rp = *(const u32x2*)(ur - NU); r.kp = *(const u32x2*)(ur - NU + 1024); r.vp = *(const u32x2*)(ur - NU + 2048); } else { r.rp = (u32x2){0u, 0u}; r.kp = r.rp; r.vp = r.rp; }
    r.ee = *(const u32x2*)(Eb + t * 1024 + chn); r.aa = *(const u32x2*)(Ab + t * 1024 + chn);
}
__device__ __forceinline__ void rwkv_scan(const Args& a, unsigned char* lds, int item, bool do_late) {
    const int tid = threadIdx.x, lane = tid & 63, wid = tid >> 6;
    const int quarter = item & 3, h = (item >> 2) & 15, b = item >> 6;
    const bf16_t* U = (const bf16_t*)(a.ws + WS_U); const bf16_t* Eb = (const bf16_t*)(a.ws + WS_E); const bf16_t* Ab = (const bf16_t*)(a.ws + WS_A);
    float* BN = (float*)(a.ws + WS_BN); bf16_t* YR = (bf16_t*)((unsigned char*)a.out + DO_YR);
    float* OP = (float*)lds;
    float* VV = OP + 2 * 10240;
    float* CC = VV + 2 * 2048;
    float* YB = CC + 2 * 64;
    if (wid >= 4) {
        const int ptid = tid - 256, cq = ptid & 15, tt0 = ptid >> 4, chn = h * 64 + 4 * cq;
        const float* mu = a.in[10];
        float mur[4], muk[4], muv[4], kkw[4], kaw[4], rkw[4];
#pragma unroll
        for (int j = 0; j < 4; ++j) { mur[j] = mu[chn + j]; muk[j] = mu[1024 + chn + j]; muv[j] = mu[2048 + chn + j]; kkw[j] = a.in[16][chn + j]; kaw[j] = a.in[17][chn + j]; rkw[j] = a.in[18][chn + j]; }
        float* lscr = (float*)(lds + 102912 + (wid - 4) * 8448);
        const int NPW = (int)gridDim.x * 4; int late_it = (int)blockIdx.x * 4 + (wid - 4); int late_sub = 0; LateTile ld_{}; float lv[8];
        RwRaw raw[2];
        rw_load(raw[0], U, Eb, Ab, b, tt0, chn); rw_load(raw[1], U, Eb, Ab, b, tt0 + 16, chn);
#pragma unroll 1
        for (int chunk = 0; chunk <= 128; ++chunk) {
            const bool late_on = do_late && chunk >= 2 && late_it < LATE_ITEMS;
            if (late_on) { if (late_sub == 0) ld_ = late_decode(a, late_it); late_load(ld_, late_sub, lv, lane); }
            if (chunk < 128) {
                float* OPb = OP + (chunk & 1) * 10240; float* VVb = VV + (chunk & 1) * 2048; float* CCb = CC + (chunk & 1) * 64;
#pragma unroll
                for (int k2i = 0; k2i < 2; ++k2i) {
                    const RwRaw rr = raw[k2i]; const int tt = tt0 + 16 * k2i;
                    const float rcf[4] = {bflo(rr.rc.x), bfhi(rr.rc.x), bflo(rr.rc.y), bfhi(rr.rc.y)}, rpf[4] = {bflo(rr.rp.x), bfhi(rr.rp.x), bflo(rr.rp.y), bfhi(rr.rp.y)};
                    const float kcf[4] = {bflo(rr.kc.x), bfhi(rr.kc.x), bflo(rr.kc.y), bfhi(rr.kc.y)}, kpf[4] = {bflo(rr.kp.x), bfhi(rr.kp.x), bflo(rr.kp.y), bfhi(rr.kp.y)};
                    const float vcf[4] = {bflo(rr.vc.x), bfhi(rr.vc.x), bflo(rr.vc.y), bfhi(rr.vc.y)}, vpf[4] = {bflo(rr.vp.x), bfhi(rr.vp.x), bflo(rr.vp.y), bfhi(rr.vp.y)};
                    const float ef[4] = {bflo(rr.ee.x), bfhi(rr.ee.x), bflo(rr.ee.y), bfhi(rr.ee.y)}, af[4] = {bflo(rr.aa.x), bfhi(rr.aa.x), bflo(rr.aa.y), bfhi(rr.aa.y)};
                    if (chunk + 1 < 128) rw_load(raw[k2i], U, Eb, Ab, b, (chunk + 1) * 32 + tt, chn);
                    float r[4], k[4], v[4], w[4], kk[4], k2[4], kka[4], wr[4]; float ss = 0.f, c1 = 0.f, c2 = 0.f, bn = 0.f;
#pragma unroll
                    for (int j = 0; j < 4; ++j) { r[j] = rcf[j] + (rpf[j] - rcf[j]) * mur[j]; k[j] = kcf[j] + (kpf[j] - kcf[j]) * muk[j]; v[j] = vcf[j] + (vpf[j] - vcf[j]) * muv[j];
                        w[j] = __expf(-ef[j]); kk[j] = k[j] * kkw[j]; ss += kk[j] * kk[j]; }
                    ss = row16_sum(ss);
                    const float inv = __builtin_amdgcn_rsqf(fmaxf(ss, 1e-24f));
#pragma unroll
                    for (int j = 0; j < 4; ++j) { kk[j] *= inv; k2[j] = k[j] * (1.f + (af[j] - 1.f) * kaw[j]); kka[j] = kk[j] * af[j]; wr[j] = w[j] * r[j];
                        c1 += kka[j] * r[j]; c2 += k2[j] * r[j]; bn += r[j] * k2[j] * rkw[j]; }
                    c1 = row16_sum(c1); c2 = row16_sum(c2); bn = row16_sum(bn);
                    float* op = OPb + tt * 320 + cq * 20;
                    *(f32x4*)(op) = (f32x4){-kk[0], -kk[1], -kk[2], -kk[3]};
                    *(f32x4*)(op + 4) = (f32x4){wr[0], wr[1], wr[2], wr[3]};
                    *(f32x4*)(op + 8) = (f32x4){w[0], w[1], w[2], w[3]};
                    *(f32x4*)(op + 12) = (f32x4){kka[0], kka[1], kka[2], kka[3]};
                    *(f32x4*)(op + 16) = (f32x4){k2[0], k2[1], k2[2], k2[3]};
                    *(f32x4*)(VVb + tt * 64 + 4 * cq) = (f32x4){v[0], v[1], v[2], v[3]};
                    if (cq == 0) { CCb[2 * tt] = c1; CCb[2 * tt + 1] = c2; if (quarter == 0) BN[((size_t)b * SEQ + chunk * 32 + tt) * 16 + h] = bn; }
                }
            }
            if (late_on) { late_stash(late_sub, lv, lscr, lane); if (++late_sub == 4) { late_flush(ld_, lscr, lane); late_sub = 0; late_it += NPW; } }
            if (chunk >= 2) {
                const int yc = chunk - 2; const float* YBb = YB + (yc & 1) * 512;
                const int t2 = ptid >> 3, pr = ptid & 7; const f32x2 yy = *(const f32x2*)(YBb + t2 * 16 + 2 * pr);
                *(unsigned*)(YR + ((size_t)b * SEQ + yc * 32 + t2) * 1024 + h * 64 + quarter * 16 + 2 * pr) = pk2(yy.x, yy.y);
            }
            __syncthreads();
        }
        if (do_late) while (late_it < LATE_ITEMS) { if (late_sub == 0) ld_ = late_decode(a, late_it); late_load(ld_, late_sub, lv, lane); late_stash(late_sub, lv, lscr, lane); if (++late_sub == 4) { late_flush(ld_, lscr, lane); late_sub = 0; late_it += NPW; } }
        {   const int yc = 127; const float* YBb = YB + (yc & 1) * 512;
            const int t2 = ptid >> 3, pr = ptid & 7; const f32x2 yy = *(const f32x2*)(YBb + t2 * 16 + 2 * pr);
            *(unsigned*)(YR + ((size_t)b * SEQ + yc * 32 + t2) * 1024 + h * 64 + quarter * 16 + 2 * pr) = pk2(yy.x, yy.y); }
    } else {
        const int q = lane & 15, rloc = wid * 4 + (lane >> 4), irow = quarter * 16 + rloc;
        f32x2 S0 = (f32x2){0.f, 0.f}, S1 = (f32x2){0.f, 0.f};
        __syncthreads();
#pragma unroll 1
        for (int chunk = 0; chunk < 128; ++chunk) {
            const float* OPb = OP + (chunk & 1) * 10240; const float* VVb = VV + (chunk & 1) * 2048; const float* CCb = CC + (chunk & 1) * 64; float* YBb = YB + (chunk & 1) * 512;
#define RW_LD(o, s_) do { const float* op_ = OPb + (s_) * 320 + q * 20; o.nkk = *(const f32x4*)(op_); o.wr = *(const f32x4*)(op_ + 4); o.w = *(const f32x4*)(op_ + 8); o.kka = *(const f32x4*)(op_ + 12); o.k2 = *(const f32x4*)(op_ + 16); \
                o.vi = VVb[(s_) * 64 + irow]; o.cc = *(const f32x2*)(CCb + 2 * (s_)); } while (0)
#define RW_STEP(o, s_) do { const f32x2 p_ = S0 * o.nkk.lo + S1 * o.nkk.hi; const f32x2 r_ = S0 * o.wr.lo + S1 * o.wr.hi; \
                const f32x2 t0_ = S0 * o.w.lo + o.vi * o.k2.lo; const f32x2 t1_ = S1 * o.w.hi + o.vi * o.k2.hi; \
                float d1 = p_.x + p_.y, d2 = r_.x + r_.y; row16_sum2(d1, d2); \
                S0 = t0_ + d1 * o.kka.lo; S1 = t1_ + d1 * o.kka.hi; YBb[(s_) * 16 + rloc] = d2 + d1 * o.cc.x + o.vi * o.cc.y; } while (0)
            RwStep o0, o1, n0, n1;
            RW_LD(o0, 0); RW_LD(o1, 1);
#pragma unroll
            for (int s = 0; s < 32; s += 2) {
                if (s + 2 < 32) { RW_LD(n0, s + 2); RW_LD(n1, s + 3); }
                __builtin_amdgcn_sched_barrier(0);
                RW_STEP(o0, s); RW_STEP(o1, s + 1);
                __builtin_amdgcn_sched_barrier(0);
                o0 = n0; o1 = n1;
            }
#undef RW_LD
#undef RW_STEP
            __syncthreads();
        }
    }
    __syncthreads();
}

__device__ __forceinline__ void rwkv_post(const Args& a) {
    const int lane = threadIdx.x & 63, gw = blockIdx.x * 8 + (threadIdx.x >> 6), NGW = gridDim.x * 8;
    const bf16_t* U = (const bf16_t*)(a.ws + WS_U); const bf16_t* Gb = (const bf16_t*)(a.ws + WS_G); const float* BN = (const float*)(a.ws + WS_BN);
    const bf16_t* YR = (const bf16_t*)((unsigned char*)a.out + DO_YR); bf16_t* YM = (bf16_t*)(a.ws + WS_HN);
    const float* mu = a.in[10]; const float* lnw = a.in[19]; const float* lnb = a.in[20];
    const int cq = lane & 15;
#pragma unroll 2
    for (int pb = gw * 4; pb < T_TOK * 16; pb += NGW * 4) {
        const int pair = pb + (lane >> 4), t = pair >> 4, h = pair & 15, ch = h * 64 + 4 * cq;
        const u32x2 yr = __builtin_nontemporal_load((const u32x2*)(YR + (size_t)t * 1024 + ch));
        const float y[4] = {bflo(yr.x), bfhi(yr.x), bflo(yr.y), bfhi(yr.y)};
        const float mean = row16_sum((y[0] + y[1]) + (y[2] + y[3])) * (1.f / 64.f);
        float vs = 0.f;
#pragma unroll
        for (int j = 0; j < 4; ++j) vs += (y[j] - mean) * (y[j] - mean);
        const float rstd = rsqrtf(row16_sum(vs) * (1.f / 64.f) + 64e-5f);
        const bf16_t* uv = U + (size_t)t * NU + 4624 + ch;
        const u32x2 vcr = __builtin_nontemporal_load((const u32x2*)uv); u32x2 vpr = (u32x2){0u, 0u}; if (t & (SEQ - 1)) vpr = *(const u32x2*)(uv - NU);
        const float vc[4] = {bflo(vcr.x), bfhi(vcr.x), bflo(vcr.y), bfhi(vcr.y)}, vp[4] = {bflo(vpr.x), bfhi(vpr.x), bflo(vpr.y), bfhi(vpr.y)};
        const u32x2 gr = __builtin_nontemporal_load((const u32x2*)(Gb + (size_t)t * 1024 + ch)); const float gt[4] = {bflo(gr.x), bfhi(gr.x), bflo(gr.y), bfhi(gr.y)};
        const float bn = BN[(size_t)t * 16 + h];
        float o[4];
#pragma unroll
        for (int j = 0; j < 4; ++j) { const float v = vc[j] + (vp[j] - vc[j]) * mu[2048 + ch + j]; o[j] = ((y[j] - mean) * rstd * lnw[ch + j] + lnb[ch + j] + bn * v) * gt[j]; }
        u32x2 w; w.x = pk2(o[0], o[1]); w.y = pk2(o[2], o[3]);
        *(u32x2*)(YM + (size_t)t * DM + 1024 + ch) = w;
    }
}

__device__ __forceinline__ void attn_item(const Args& a, unsigned char* lds, int item) {
    const int tid = threadIdx.x, lane = tid & 63, wid = tid >> 6, fr = lane & 15, fq = lane >> 4;
    const int qt = item & 31, hd = (item >> 5) & 3, b = item >> 7;
    const int t0 = b * SEQ + qt * 128;
    const bf16_t* Q = (const bf16_t*)(a.ws + WS_U); bf16_t* Ob = (bf16_t*)(a.ws + WS_HN); const bf16_t* Kx = (const bf16_t*)(a.ws + WS_KX); const bf16_t* Vt = (const bf16_t*)(a.ws + WS_VT);
    bf16_t* Qs = (bf16_t*)lds; bf16_t* Ks = Qs + 128 * 72; bf16_t* Vs = (bf16_t*)lds; bf16_t* Ps = (bf16_t*)(lds + 55296);
    f32x4 s[16];
#pragma unroll
    for (int f = 0; f < 16; ++f) s[f] = (f32x4){0.f, 0.f, 0.f, 0.f};
    u32x4 qr[2], kr[4];
#define AT_LOADQK(dc_) do { _Pragma("unroll") for (int i_ = 0; i_ < 2; ++i_) { const int idx = tid + 512 * i_, r = idx >> 3, ch = idx & 7; qr[i_] = __builtin_nontemporal_load((const u32x4*)(Q + (size_t)(t0 + r) * DM + hd * 512 + (dc_) * 64 + ch * 8)); } \
        _Pragma("unroll") for (int i_ = 0; i_ < 4; ++i_) { const int idx = tid + 512 * i_, r = idx >> 3, ch = idx & 7; kr[i_] = *(const u32x4*)(Kx + (size_t)(b * 256 + r) * DM + hd * 512 + (dc_) * 64 + ch * 8); } } while (0)
    AT_LOADQK(0);
#pragma unroll 1
    for (int dc = 0; dc < 8; ++dc) {
#pragma unroll
        for (int i_ = 0; i_ < 2; ++i_) { const int idx = tid + 512 * i_, r = idx >> 3, ch = idx & 7; *(u32x4*)(Qs + r * 72 + ch * 8) = qr[i_]; }
#pragma unroll
        for (int i_ = 0; i_ < 4; ++i_) { const int idx = tid + 512 * i_, r = idx >> 3, ch = idx & 7; *(u32x4*)(Ks + r * 72 + ch * 8) = kr[i_]; }
        __syncthreads();
        if (dc + 1 < 8) AT_LOADQK(dc + 1);
        wave_mma<16, 64, false>(s, Qs + (16 * wid) * 72, 72, Ks, 72, fr, fq);
        __syncthreads();
    }
#undef AT_LOADQK
    u32x4 vr[4];
#define AT_LOADV(dc_) do { _Pragma("unroll") for (int i_ = 0; i_ < 4; ++i_) { const int idx = tid + 512 * i_, r = idx >> 5, ch = idx & 31; vr[i_] = *(const u32x4*)(Vt + (size_t)(hd * 512 + (dc_) * 64 + r) * 1024 + b * 256 + ch * 8); } } while (0)
    AT_LOADV(0);
    const float scale = 0.04419417382415922f;
#pragma unroll
    for (int j = 0; j < 4; ++j) {
        float mx = s[0][j];
#pragma unroll
        for (int f = 1; f < 16; ++f) mx = fmaxf(mx, s[f][j]);
        mx = row16_max(mx);
        float sum = 0.f;
#pragma unroll
        for (int f = 0; f < 16; ++f) { const float p = __expf((s[f][j] - mx) * scale); s[f][j] = p; sum += p; }
        sum = row16_sum(sum);
        const float inv = __builtin_amdgcn_rcpf(sum);
#pragma unroll
        for (int f = 0; f < 16; ++f) Ps[(16 * wid + 4 * fq + j) * 264 + 16 * f + fr] = f2bf(s[f][j] * inv);
    }
#pragma unroll 1
    for (int dc = 0; dc < 8; ++dc) {
        __syncthreads();
#pragma unroll
        for (int i_ = 0; i_ < 4; ++i_) { const int idx = tid + 512 * i_, r = idx >> 5, ch = idx & 31; *(u32x4*)(Vs + r * 264 + ch * 8) = vr[i_]; }
        __syncthreads();
        if (dc + 1 < 8) AT_LOADV(dc + 1);
        f32x4 o[4];
#pragma unroll
        for (int f = 0; f < 4; ++f) o[f] = (f32x4){0.f, 0.f, 0.f, 0.f};
        wave_mma<4, 256, true>(o, Ps + (16 * wid) * 264, 264, Vs, 264, fr, fq);
#pragma unroll
        for (int f = 0; f < 4; ++f) { u32x2 w; w.x = pk2(o[f][0], o[f][1]); w.y = pk2(o[f][2], o[f][3]);
            *(u32x2*)(Ob + (size_t)(t0 + 16 * wid + fr) * DM + hd * 512 + dc * 64 + 16 * f + 4 * fq) = w; }
    }
#undef AT_LOADV
    __syncthreads();
}


#define XB_TMO      128
#define XB_XCNT(j)  (256  + 64 * (j))
#define XB_XSUB(j)  (1280 + 64 * (j))
#define XB_XGEN(j)  (2304 + 64 * (j))
#define XB_TOP      3328
#define XB_TOPGEN   3392
#define XCD_BAR_WORDS 3456
#define XB_SPIN_CAP (1u << 18)
__device__ __forceinline__ unsigned xb_ld(unsigned* p)              { return __hip_atomic_load(p, __ATOMIC_RELAXED, __HIP_MEMORY_SCOPE_AGENT); }
__device__ __forceinline__ unsigned xb_add(unsigned* p, unsigned v) { return __hip_atomic_fetch_add(p, v, __ATOMIC_RELAXED, __HIP_MEMORY_SCOPE_AGENT); }
__device__ __forceinline__ unsigned xb_xcc_id() { return (unsigned)__builtin_amdgcn_s_getreg((3 << 11) | 20) & 0xFu; }
#define XB_SPIN(cond, bar) do { unsigned _sp = 0; while (cond) { __builtin_amdgcn_s_sleep(1); \
    if ((++_sp & 255u) == 0u) { if (xb_ld(&(bar)[XB_TMO])) break; if (_sp > XB_SPIN_CAP) { atomicAdd(&(bar)[XB_TMO], 1u); break; } } } } while (0)
struct XcdBarrier { unsigned* bar; unsigned x; volatile LAS unsigned* st; };
__device__ __forceinline__ XcdBarrier xcd_barrier_post(unsigned* bar, volatile LAS unsigned* st) {
    XcdBarrier b; b.bar = bar; b.x = xb_xcc_id(); b.st = st;
    if (threadIdx.x == 0) (void)xb_add(&bar[XB_XCNT(b.x)], 1u);
    return b;
}
__device__ __forceinline__ void xcd_barrier_complete(unsigned* bar, unsigned x, unsigned& nloc, unsigned& nx) {
    const unsigned G = gridDim.x * gridDim.y * gridDim.z;
    unsigned sum, cnt, mine, sp = 0u;
    for (;;) {
        sum = 0u; cnt = 0u; mine = 0u;
#pragma unroll
        for (unsigned j = 0; j < 16; ++j) { const unsigned c = xb_ld(&bar[XB_XCNT(j)]); sum += c; cnt += (c > 0u) ? 1u : 0u; mine = (j == x) ? c : mine; }
        if (sum == G) break;
        __builtin_amdgcn_s_sleep(1);
        if ((++sp & 255u) == 0u) { if (xb_ld(&bar[XB_TMO])) break; if (sp > XB_SPIN_CAP) { atomicAdd(&bar[XB_TMO], 1u); break; } }
    }
    nloc = mine > 0u ? mine : 1u; nx = cnt > 0u ? cnt : 1u;
}
__device__ __forceinline__ void xcd_barrier(const XcdBarrier& b) {
    asm volatile("s_waitcnt vmcnt(0)" ::: "memory");
    __syncthreads();
    if (threadIdx.x == 0) {
        unsigned* bar = b.bar;
        __builtin_amdgcn_s_waitcnt(0);
        unsigned nloc = b.st[0], nx = b.st[1];
        if (nloc == 0u) { xcd_barrier_complete(bar, b.x, nloc, nx); b.st[0] = nloc; b.st[1] = nx; }
        const unsigned old = xb_add(&bar[XB_XSUB(b.x)], 1u);
        const unsigned gen = old / nloc;
        if (old + 1u == (gen + 1u) * nloc) {
            __builtin_amdgcn_fence(__ATOMIC_RELEASE, "agent");
            asm volatile("s_waitcnt vmcnt(0)" ::: "memory");
            const unsigned og = xb_add(&bar[XB_TOP], 1u);
            const unsigned tg = og / nx;
            if (og + 1u == (tg + 1u) * nx) xb_add(&bar[XB_TOPGEN], 1u);
            else XB_SPIN(xb_ld(&bar[XB_TOPGEN]) == tg, bar);
            __builtin_amdgcn_fence(__ATOMIC_ACQUIRE, "agent");
            xb_add(&bar[XB_XGEN(b.x)], 1u);
            asm volatile("s_waitcnt vmcnt(0)" ::: "memory");
        } else {
            XB_SPIN(xb_ld(&bar[XB_XGEN(b.x)]) == gen, bar);
            __builtin_amdgcn_fence(__ATOMIC_ACQUIRE, "agent");
            asm volatile("s_waitcnt vmcnt(0)" ::: "memory");
        }
    }
    __syncthreads();
}

constexpr int NPHASE = 14;
#ifndef REP_PH
#define REP_PH -1
#endif
#define NREP(k) ((k) == REP_PH ? 2 : 1)
__global__ void __launch_bounds__(512, 2) hymba_fwd(Args a) {
    extern __shared__ __attribute__((aligned(16))) unsigned char lds[];
    cg::grid_group grid = cg::this_grid();
    unsigned char* ws = a.ws;
    const int G = gridDim.x, bid = blockIdx.x;
    volatile LAS unsigned* xst = (volatile LAS unsigned*)((LAS unsigned char*)lds + 139264);
    if (threadIdx.x < 2) xst[threadIdx.x] = 0u;
    __syncthreads();
    const int vb = (G % 8 == 0) ? (bid % 8) * (G / 8) + bid / 8 : bid;
    const XcdBarrier xbar = xcd_barrier_post((unsigned*)(a.ws + WS_BAR), xst);
    if (a.ph_hi < 0) grid.sync();
#define IN(k) (a.ph_lo <= (k) && (k) < a.ph_hi)
#define SEAM(k) do { if (a.ph_lo <= (k) && (k) + 1 < a.ph_hi) xcd_barrier(xbar); } while (0)
    bf16_t* HN = (bf16_t*)(ws + WS_HN); bf16_t* Ub = (bf16_t*)(ws + WS_U);
    if (IN(0)) for (int rp_ = 0; rp_ < NREP(0); ++rp_) p0_prologue(a, lds);
    SEAM(0);
    if (IN(1)) for (int rp_ = 0; rp_ < NREP(1); ++rp_) run_gemm(lds, HN, (const bf16_t*)(ws + WS_WIN), T_TOK, NU, DM, pg8::EpiBf16{Ub, NU, 0, nullptr});
    SEAM(1);
    if (IN(2)) for (int rp_ = 0; rp_ < NREP(2); ++rp_) { lora_prep(a); for (int it = vb; it < 256; it += G) ssd_passA(a, lds, it); }
    SEAM(2);
    if (IN(3)) {
        const pg8::EpiLora EL{(bf16_t*)(ws + WS_E), (bf16_t*)(ws + WS_A), (bf16_t*)(ws + WS_G), a.in[11], a.in[13]};
        const bf16_t* LAp = (const bf16_t*)((unsigned char*)a.out + DO_LA);
        if (G == 256) {
            if (bid < 32) run_gemm(lds, (const bf16_t*)(ws + WS_MN), (const bf16_t*)(ws + WS_WK), 1024, DM, DM, pg8::EpiBf16{(bf16_t*)(ws + WS_KX), DM, 0, nullptr}, 32, bid);
            else if (bid < 64) run_gemm(lds, (const bf16_t*)(ws + WS_WV), (const bf16_t*)(ws + WS_MN), DM, 1024, DM, pg8::EpiBf16{(bf16_t*)(ws + WS_VT), 1024, 0, nullptr}, 32, bid - 32);
            else run_gemm(lds, LAp, (const bf16_t*)(ws + WS_LORA), T_TOK, 3072, 512, EL, 192, bid - 64);
        } else {
            run_gemm(lds, (const bf16_t*)(ws + WS_MN), (const bf16_t*)(ws + WS_WK), 1024, DM, DM, pg8::EpiBf16{(bf16_t*)(ws + WS_KX), DM, 0, nullptr});
            run_gemm(lds, (const bf16_t*)(ws + WS_WV), (const bf16_t*)(ws + WS_MN), DM, 1024, DM, pg8::EpiBf16{(bf16_t*)(ws + WS_VT), 1024, 0, nullptr});
            run_gemm(lds, LAp, (const bf16_t*)(ws + WS_LORA), T_TOK, 3072, 512, EL);
        }
        ssd_state_scan(a);
    }
    SEAM(3);
    if (IN(4)) for (int rp_ = 0; rp_ < NREP(4); ++rp_) {
        for (int r2 = 0; r2 < NREP(41); ++r2) for (int it = vb; it < 256; it += G) ssd_passC(a, lds, it);
        for (int r2 = 0; r2 < NREP(42); ++r2) for (int it = vb; it < 256; it += G) rwkv_scan(a, lds, it, it == vb);
    }
    SEAM(4);
    if (IN(5)) for (int rp_ = 0; rp_ < NREP(5); ++rp_) rwkv_post(a);
    SEAM(5);
    bf16_t* Xb = (bf16_t*)(ws + WS_E);
    bf16_t* Fb = (bf16_t*)(ws + WS_HN);
    float* SS1 = (float*)(ws + WS_SS); float* SS2 = SS1 + T_TOK; float* SS3 = SS2 + T_TOK;
    if (IN(6)) for (int rp_ = 0; rp_ < NREP(6); ++rp_) run_gemm(lds, HN, (const bf16_t*)(ws + WS_WOUT), T_TOK, DM, DM, pg8::EpiResBf16<false>{a.in[0], Xb, DM, SS1});
    SEAM(6);
    if (IN(8)) for (int rp_ = 0; rp_ < NREP(8); ++rp_) run_gemm(lds, Xb, (const bf16_t*)(ws + WS_WQ), T_TOK, DM, DM, pg8::EpiBf16{Ub, DM, 0, SS1});
    SEAM(8);
    if (IN(9)) for (int rp_ = 0; rp_ < NREP(9); ++rp_) for (int it = vb; it < 512; it += G) attn_item(a, lds, it);
    SEAM(9);
    if (IN(10)) run_gemm(lds, HN, (const bf16_t*)(ws + WS_WO), T_TOK, DM, DM, pg8::EpiResBf16<true>{Xb, Xb, DM, SS2});
    SEAM(10);
    if (IN(12)) for (int rp_ = 0; rp_ < NREP(12); ++rp_) run_gemm(lds, Xb, (const bf16_t*)(ws + WS_W1), T_TOK, DFF, DM, pg8::EpiBf16{Fb, DFF, 1, SS2});
    SEAM(12);
    if (IN(13)) run_gemm(lds, Fb, (const bf16_t*)(ws + WS_W2), T_TOK, DM, DFF, pg8::EpiResBf16<true>{Xb, Xb, DM, SS3});
    SEAM(13);
    if (IN(14)) { const f32x4* g4 = (const f32x4*)a.in[31];
#pragma unroll 4
        for (int idx = bid * 512 + threadIdx.x; idx < T_TOK * 256; idx += G * 512) {
            const int row = idx >> 8, c8 = idx & 255; const float rs = rsqrtf(SS3[row] * (1.f / 2048.f) + 1e-6f);
            const u32x4 r = __builtin_nontemporal_load((const u32x4*)(Xb + (size_t)row * DM + c8 * 8)); const f32x4 ga = g4[c8 * 2], gb = g4[c8 * 2 + 1];
            f32x4 o0 = (f32x4){bflo(r.x), bfhi(r.x), bflo(r.y), bfhi(r.y)}, o1 = (f32x4){bflo(r.z), bfhi(r.z), bflo(r.w), bfhi(r.w)};
            o0 = o0 * rs * ga; o1 = o1 * rs * gb;
            f32x4* op = (f32x4*)(a.out + (size_t)row * DM + c8 * 8); __builtin_nontemporal_store(o0, op); __builtin_nontemporal_store(o1, op + 1); } }
#undef IN
#undef SEAM
}

extern "C" void kernel_launch(void* const* d_in, const int* in_sizes, int n_in, void* d_out, int out_size, void* d_ws, size_t ws_size, hipStream_t stream) {
    static int grid = 0;
    if (grid == 0) {
        if (n_in != 32 || out_size != T_TOK * DM || ws_size < WS_END) { fprintf(stderr, "kernel_launch: unexpected shapes (n_in %d out %d ws %zu)\n", n_in, out_size, ws_size); grid = -1; return; }
        int dev = 0, cus = 0, per_cu = 0;
        (void)hipGetDevice(&dev); (void)hipDeviceGetAttribute(&cus, hipDeviceAttributeMultiprocessorCount, dev);
        if (hipFuncSetAttribute((const void*)hymba_fwd, hipFuncAttributeMaxDynamicSharedMemorySize, LDS_BYTES) != hipSuccess) { fprintf(stderr, "kernel_launch: hipFuncSetAttribute failed\n"); grid = -1; return; }
        if (hipOccupancyMaxActiveBlocksPerMultiprocessor(&per_cu, (const void*)hymba_fwd, 512, LDS_BYTES) != hipSuccess || per_cu < 1) per_cu = 1;
        (void)hipGetLastError();
        grid = cus * 1;
        if (grid <= 0) grid = 256;
    }
    if (grid < 0) return;
    (void)hipMemsetAsync((char*)d_ws + WS_BAR, 0, XCD_BAR_WORDS * 4, stream);
    Args a{};
    for (int i = 0; i < 32; ++i) a.in[i] = (const float*)d_in[i];
    a.out = (float*)d_out; a.ws = (unsigned char*)d_ws; a.ph_lo = 0; a.ph_hi = NPHASE + 1;
    void* args[] = {&a};
    hipError_t e = hipLaunchCooperativeKernel((const void*)hymba_fwd, dim3(grid), dim3(512), args, LDS_BYTES, stream);
    if (e != hipSuccess) fprintf(stderr, "kernel_launch: cooperative launch failed: %s (grid %d)\n", hipGetErrorString(e), grid);
}
```
